# Optimizing an MI355X kernel written in HIP

```python
import jax, jax.numpy as jnp
from jax import lax
import numpy as np

D_MODEL = 2048
BATCH = 4
SEQ = 4096
DEPTH = 1

N_META = 16
D_LRU = D_MODEL // 2
N_LRU_HEADS = 16
LRU_BLOCK = D_LRU // N_LRU_HEADS
LRU_CONV_WIDTH = 4
LRU_C = 8.0
D_SCONV = D_MODEL - D_LRU
N_SCONV_GROUPS = 16
SCONV_BLOCK = D_SCONV // N_SCONV_GROUPS
SCONV_WIDTH = 3
D_FF = ((8 * D_MODEL // 3 + 127) // 128) * 128
IN_COLS = 2 * D_LRU + 3 * D_SCONV
EPS = 1e-6

kernel_name = "hymba_lru_shortconv_macaron"


def rmsnorm(x, g):
    xf = x.astype(jnp.float32)
    y = xf * lax.rsqrt(jnp.mean(xf * xf, axis=-1, keepdims=True) + EPS)
    return (y * g.astype(jnp.float32)).astype(x.dtype)


def group_rmsnorm(x, g, n_groups):
    b, t, c = x.shape
    xf = x.astype(jnp.float32).reshape(b, t, n_groups, c // n_groups)
    y = xf * lax.rsqrt(jnp.mean(xf * xf, axis=-1, keepdims=True) + EPS)
    return (y.reshape(b, t, c) * g.astype(jnp.float32)).astype(x.dtype)


def causal_depthwise_conv(x, w):
    k = w.shape[0]
    return lax.conv_general_dilated(
        x, w[:, None, :].astype(x.dtype), window_strides=(1,),
        padding=[(k - 1, 0)], dimension_numbers=("NWC", "WIO", "NWC"),
        feature_group_count=x.shape[-1])


def swiglu(x, w_gate, w_up, w_down):
    return (jax.nn.silu(x @ w_gate) * (x @ w_up)) @ w_down


def rg_lru(x, w_a, b_a, w_x, b_x, lam):
    bn, t, c = x.shape
    xh = x.reshape(bn, t, N_LRU_HEADS, LRU_BLOCK)
    gate_a = jax.nn.sigmoid(jnp.einsum("bthi,hij->bthj", xh, w_a).reshape(bn, t, c) + b_a)
    gate_x = jax.nn.sigmoid(jnp.einsum("bthi,hij->bthj", xh, w_x).reshape(bn, t, c) + b_x)
    log_a = -LRU_C * gate_a.astype(jnp.float32) * jax.nn.softplus(-lam.astype(jnp.float32))
    a = jnp.exp(log_a)
    mult = jnp.sqrt(-jnp.expm1(2.0 * log_a))
    u = mult * (gate_x * x).astype(jnp.float32)

    def combine(left, right):
        a_l, b_l = left
        a_r, b_r = right
        return a_r * a_l, a_r * b_l + b_r

    _, h = lax.associative_scan(combine, (a, u), axis=1)
    return h.astype(x.dtype)


def setup_inputs(seed: int = 0) -> dict:
    key = jax.random.key(seed)
    ks = iter(jax.random.split(key, 40))
    f32 = jnp.float32
    L = DEPTH

    def nrm(shape, fan_in):
        return jax.random.normal(next(ks), shape, f32) * (fan_in ** -0.5)

    def gain(shape):
        return 1.0 + 0.02 * jax.random.normal(next(ks), shape, f32)

    def bias(shape):
        return 0.01 * jax.random.normal(next(ks), shape, f32)

    x = jax.random.normal(next(ks), (BATCH, SEQ, D_MODEL), f32)
    meta_tokens = jax.random.normal(next(ks), (N_META, D_MODEL), f32)

    a_c = jax.random.uniform(next(ks), (L, D_LRU), f32, 0.9, 0.999)
    s = a_c ** (1.0 / LRU_C)
    lru_lambda = jnp.log(s) - jnp.log1p(-s)

    return {
        "x": x,
        "meta_tokens": meta_tokens,
        "ffn1_pre_g": gain((L, D_MODEL)),
        "ffn1_w_gate": nrm((L, D_MODEL, D_FF), D_MODEL),
        "ffn1_w_up": nrm((L, D_MODEL, D_FF), D_MODEL),
        "ffn1_w_down": nrm((L, D_FF, D_MODEL), D_FF),
        "ffn1_post_g": gain((L, D_MODEL)),
        "mix_pre_g": gain((L, D_MODEL)),
        "w_in": nrm((L, D_MODEL, IN_COLS), D_MODEL),
        "lru_conv_w": nrm((L, LRU_CONV_WIDTH, D_LRU), LRU_CONV_WIDTH),
        "lru_conv_b": bias((L, D_LRU)),
        "lru_w_a": nrm((L, N_LRU_HEADS, LRU_BLOCK, LRU_BLOCK), LRU_BLOCK),
        "lru_b_a": bias((L, D_LRU)),
        "lru_w_x": nrm((L, N_LRU_HEADS, LRU_BLOCK, LRU_BLOCK), LRU_BLOCK),
        "lru_b_x": bias((L, D_LRU)),
        "lru_lambda": lru_lambda,
        "sconv_w": nrm((L, SCONV_WIDTH, D_SCONV), SCONV_WIDTH),
        "lru_out_g": gain((L, D_LRU)),
        "sconv_out_g": gain((L, D_SCONV)),
        "w_out": nrm((L, D_MODEL, D_MODEL), D_MODEL),
        "mix_post_g": gain((L, D_MODEL)),
        "ffn2_pre_g": gain((L, D_MODEL)),
        "ffn2_w_gate": nrm((L, D_MODEL, D_FF), D_MODEL),
        "ffn2_w_up": nrm((L, D_MODEL, D_FF), D_MODEL),
        "ffn2_w_down": nrm((L, D_FF, D_MODEL), D_FF),
        "ffn2_post_g": gain((L, D_MODEL)),
    }


def reference(x, meta_tokens, ffn1_pre_g, ffn1_w_gate, ffn1_w_up, ffn1_w_down, ffn1_post_g,
              mix_pre_g, w_in, lru_conv_w, lru_conv_b, lru_w_a, lru_b_a, lru_w_x, lru_b_x,
              lru_lambda, sconv_w, lru_out_g, sconv_out_g, w_out, mix_post_g,
              ffn2_pre_g, ffn2_w_gate, ffn2_w_up, ffn2_w_down, ffn2_post_g):
    bn = x.shape[0]
    meta = jnp.broadcast_to(meta_tokens.astype(x.dtype)[None], (bn, N_META, x.shape[-1]))
    h = jnp.concatenate([meta, x], axis=1)
    splits = [D_LRU, 2 * D_LRU, 2 * D_LRU + D_SCONV, 2 * D_LRU + 2 * D_SCONV]

    for l in range(DEPTH):
        f = swiglu(rmsnorm(h, ffn1_pre_g[l]), ffn1_w_gate[l], ffn1_w_up[l], ffn1_w_down[l])
        h = h + 0.5 * rmsnorm(f, ffn1_post_g[l])

        u = rmsnorm(h, mix_pre_g[l])
        z = u @ w_in[l]
        y_lru, x_lru, b_sc, c_sc, v_sc = jnp.split(z, splits, axis=-1)

        x_lru = causal_depthwise_conv(x_lru, lru_conv_w[l]) + lru_conv_b[l]
        lru_out = rg_lru(x_lru, lru_w_a[l], lru_b_a[l], lru_w_x[l], lru_b_x[l], lru_lambda[l])
        lru_out = lru_out * jax.nn.gelu(y_lru, approximate=True)

        sc_out = b_sc * causal_depthwise_conv(c_sc * v_sc, sconv_w[l])

        mixed = jnp.concatenate([
            group_rmsnorm(lru_out, lru_out_g[l], N_LRU_HEADS),
            group_rmsnorm(sc_out, sconv_out_g[l], N_SCONV_GROUPS)], axis=-1)
        h = h + rmsnorm(mixed @ w_out[l], mix_post_g[l])

        f = swiglu(rmsnorm(h, ffn2_pre_g[l]), ffn2_w_gate[l], ffn2_w_up[l], ffn2_w_down[l])
        h = h + 0.5 * rmsnorm(f, ffn2_post_g[l])

    return h[:, N_META:]
```

```cpp
#include <hip/hip_runtime.h>
#include <hip/hip_cooperative_groups.h>
#include <cstdio>
namespace cg = cooperative_groups;

#ifndef PHMASK
#define PHMASK 0xFFF
#endif
#ifndef REPMASK
#define REPMASK 0
#endif
#ifndef ONE_LAUNCH
#define ONE_LAUNCH 1
#endif

#define LAS __attribute__((address_space(3)))
typedef unsigned short bf16_t;
typedef short bf16x8 __attribute__((ext_vector_type(8)));
typedef float f32x4 __attribute__((ext_vector_type(4)));
typedef unsigned u32x4 __attribute__((ext_vector_type(4)));
typedef unsigned u32x2 __attribute__((ext_vector_type(2)));

constexpr int D = 2048, DFF = 5504, DL = 1024, NINC = 5120, SEQ = 4096, NBATCH = 4, NMETA = 16;
constexpr int MX = NBATCH * SEQ;
constexpr int MROWS = MX + NMETA;
constexpr int NTILE = 65;
constexpr float EPS = 1e-6f;
constexpr int NPHASE = 12;
constexpr int LDS_MAIN = 131072, LDS_RS_OFF = LDS_MAIN + 64, LDS_RS_UNITS = 24, LDS_BYTES = LDS_RS_OFF + LDS_RS_UNITS * 1024;

constexpr size_t SZ_WA = (size_t)2 * DFF * D * 2, SZ_WB = (size_t)D * DFF * 2, SZ_WIN = (size_t)NINC * D * 2, SZ_WOUT = (size_t)D * D * 2;
constexpr size_t WS_W1A = 0, WS_W1B = WS_W1A + SZ_WA, WS_WIN = WS_W1B + SZ_WB, WS_WOUT = WS_WIN + SZ_WIN, WS_W2A = WS_WOUT + SZ_WOUT, WS_W2B = WS_W2A + SZ_WA;
constexpr size_t WS_ABUF = WS_W2B + SZ_WB;
constexpr size_t WS_ACT = WS_ABUF + (size_t)MROWS * D * 2;
constexpr size_t WS_F = WS_ACT + (size_t)MROWS * DFF * 2;
constexpr size_t WS_Z = WS_ACT;
constexpr size_t WS_SUMA = WS_F + (size_t)MROWS * D * 2;
constexpr size_t WS_SUMH = WS_SUMA + (size_t)NBATCH * NTILE * DL * 4;
constexpr size_t WS_BAR = WS_SUMH + (size_t)NBATCH * NTILE * DL * 4;
constexpr size_t WS_RS = WS_BAR + 16384;
constexpr size_t WS_END = WS_RS + 65792;
static_assert((size_t)MROWS * NINC * 2 <= (size_t)MROWS * DFF * 2 + (size_t)MROWS * D * 2, "Z must fit in ACT+F");

struct Params { const float* in[26]; float* out; unsigned char* ws; int ph_lo, ph_hi; };

__device__ __forceinline__ unsigned cvt_pk_bf16(float lo, float hi) { unsigned r; asm volatile("v_cvt_pk_bf16_f32 %0, %1, %2" : "=v"(r) : "v"(lo), "v"(hi)); return r; }
__device__ __forceinline__ bf16_t f2bf(float x) { return (bf16_t)(cvt_pk_bf16(x, 0.f) & 0xffffu); }
__device__ __forceinline__ float bf2f(bf16_t h) { return __uint_as_float(((unsigned)h) << 16); }
__device__ __forceinline__ float bflo(unsigned w) { return __uint_as_float(w << 16); }
__device__ __forceinline__ float bfhi(unsigned w) { return __uint_as_float(w & 0xffff0000u); }
__device__ __forceinline__ float wave_sum(float v) {
#pragma unroll
    for (int o = 32; o >= 1; o >>= 1) v += __shfl_xor(v, o);
    return v;
}
template <int CTRL> __device__ __forceinline__ float dpp_f(float v) { return __builtin_bit_cast(float, __builtin_amdgcn_update_dpp(0, __builtin_bit_cast(int, v), CTRL, 0xf, 0xf, true)); }
__device__ __forceinline__ float row16_sum(float v) {
    v += dpp_f<0xB1>(v); v += dpp_f<0x4E>(v); v += dpp_f<0x141>(v); v += dpp_f<0x140>(v); return v;
}
__device__ __forceinline__ float wave64_sum(float v) {
    const float r = row16_sum(v); const int ri = __builtin_bit_cast(int, r);
    return __builtin_bit_cast(float, __builtin_amdgcn_readlane(ri, 0)) + __builtin_bit_cast(float, __builtin_amdgcn_readlane(ri, 16)) + __builtin_bit_cast(float, __builtin_amdgcn_readlane(ri, 32)) + __builtin_bit_cast(float, __builtin_amdgcn_readlane(ri, 48));
}
__device__ __forceinline__ float silu_f(float g) { return g * __builtin_amdgcn_rcpf(1.0f + __expf(-g)); }
__device__ __forceinline__ float sigmoid_f(float g) { return 1.0f / (1.0f + __expf(-g)); }
__device__ __forceinline__ float gelu_tanh_f(float y) { const float t = tanhf(0.7978845608028654f * (y + 0.044715f * y * y * y)); return 0.5f * y * (1.0f + t); }
__device__ __forceinline__ int zrow(int b, int s) { return s < NMETA ? MX + s : b * SEQ + (s - NMETA); }

namespace pg8 {
constexpr int BM = 256, BK = 64, HALF = 128, HTB = HALF * BK * 2, STAGE_BYTES = 8 * HTB, NXCD = 8, WGM = 8;
__device__ __forceinline__ int lds_byte(int r, int c) { const int st = (r >> 4) * 2 + (c >> 5), rr = r & 15, cc = c & 31, ob = rr * 64 + cc * 2; return st * 1024 + (ob ^ (((ob >> 9) & 1) << 5)); }
__device__ __forceinline__ void stage_rc(int b, int& R, int& C) { const int st = b / 1024, sb = b % 1024, swz = sb ^ (((sb >> 9) & 1) << 5); R = (st >> 1) * 16 + swz / 64; C = (st & 1) * 32 + (swz % 64) / 2; }
__device__ __forceinline__ int perm32(int rho) { const int n = rho >> 4, i = rho & 15; return 8 * (i >> 2) + 4 * n + (i & 3); }
struct Unit { int pm, pn; };
struct Gemm { const bf16_t* A; const bf16_t* Bt; int M, N, K; };
struct StaticOrder {
    int nM, nN, nwg, G, c;
    __device__ void init(int M, int N, int G_, int c_) { nM = M / BM; nN = N / BM; nwg = nM * nN; G = G_; c = c_; }
    __device__ bool next(int i, Unit& u) const {
        const long L = (long)i * G + c; if (L >= nwg) return false;
        int wgid = (int)L; { const int q = nwg / NXCD, r = nwg % NXCD, xcd = wgid % NXCD, off = wgid / NXCD; wgid = (xcd < r ? xcd * (q + 1) : r * (q + 1) + (xcd - r) * q) + off; }
        const int nig = WGM * nN, gid = wgid / nig, fm = gid * WGM, gsz = (nM - fm) < WGM ? (nM - fm) : WGM;
        u.pm = fm + ((wgid % nig) % gsz); u.pn = (wgid % nig) / gsz; return true;
    }
};
struct EpiBf16 {
    static constexpr bool PERM = true;
    bf16_t* O; int ldc; const float* rs;
    __device__ __forceinline__ void operator()(const f32x4 (&acc)[2][2][4][2], const Unit& u, int wr, int wc, int fr, int fq, const LAS float* rsl) const {
        const int row0 = u.pm * BM + wr * 64 + fr, col0 = u.pn * BM + wc * 32 + 8 * fq;
#pragma unroll
        for (int ai = 0; ai < 2; ++ai)
#pragma unroll
            for (int m = 0; m < 4; ++m) { bf16_t* rowp = O + (size_t)(row0 + ai * HALF + m * 16) * ldc + col0; const float sc = rs ? rsl[wr * 64 + fr + ai * HALF + m * 16] : 1.0f;
#pragma unroll
                for (int bj = 0; bj < 2; ++bj) { const f32x4 v0 = acc[ai][bj][m][0] * sc, v1 = acc[ai][bj][m][1] * sc;
                    u32x4 w; w.x = cvt_pk_bf16(v0[0], v0[1]); w.y = cvt_pk_bf16(v0[2], v0[3]); w.z = cvt_pk_bf16(v1[0], v1[1]); w.w = cvt_pk_bf16(v1[2], v1[3]);
                    *(u32x4*)(rowp + bj * HALF) = w; } }
    }
};
struct EpiSwiglu {
    static constexpr bool PERM = true;
    bf16_t* O; int ldc; const float* rs;
    __device__ __forceinline__ void operator()(const f32x4 (&acc)[2][2][4][2], const Unit& u, int wr, int wc, int fr, int fq, const LAS float* rsl) const {
        const int row0 = u.pm * BM + wr * 64 + fr, col0 = u.pn * HALF + wc * 32 + 8 * fq;
#pragma unroll
        for (int ai = 0; ai < 2; ++ai)
#pragma unroll
            for (int m = 0; m < 4; ++m) { bf16_t* rowp = O + (size_t)(row0 + ai * HALF + m * 16) * ldc + col0;
                const float sc = rsl[wr * 64 + fr + ai * HALF + m * 16];
                const f32x4 g0 = acc[ai][0][m][0] * sc, g1 = acc[ai][0][m][1] * sc, u0 = acc[ai][1][m][0] * sc, u1 = acc[ai][1][m][1] * sc;
                float v[8];
#pragma unroll
                for (int j = 0; j < 4; ++j) { v[j] = silu_f(g0[j]) * u0[j]; v[4 + j] = silu_f(g1[j]) * u1[j]; }
                u32x4 w; w.x = cvt_pk_bf16(v[0], v[1]); w.y = cvt_pk_bf16(v[2], v[3]); w.z = cvt_pk_bf16(v[4], v[5]); w.w = cvt_pk_bf16(v[6], v[7]);
                *(u32x4*)rowp = w; }
    }
};

template <class Epi>
__device__ __forceinline__ void gemm_phase(LAS unsigned char* lds, const Gemm g, const StaticOrder& S, const Epi& E, const int tid) {
    const int wid = __builtin_amdgcn_readfirstlane(tid >> 6), lane = tid & 63, wr = wid >> 2, wc = wid & 3, fr = lane & 15, fq = lane >> 4;
    const int K = g.K, nt = K / BK;
    unsigned voffA[2], voffB[2];
#pragma unroll
    for (int i = 0; i < 2; ++i) { int R, C; stage_rc(tid * 16 + i * 8192, R, C); const int Rb = Epi::PERM ? ((R & ~31) + perm32(R & 31)) : R;
        voffA[i] = (unsigned)(R * K + C) * 2u; voffB[i] = (unsigned)(Rb * K + C) * 2u; }
    const size_t kstep = (size_t)(BK * 2);
    const size_t hstep = (size_t)HALF * K * 2;
    const size_t tstep = 2 * hstep;
    const unsigned ldsw = (unsigned)wid * 1024u;
    const int aoff = lds_byte(wr * 64 + fr, fq * 8), boff = lds_byte(wc * 32 + fr, fq * 8);
#define PG8_SA(b, h) (((b) * 2 + (h)) * HTB)
#define PG8_SB(b, h) ((4 + (b) * 2 + (h)) * HTB)
#define PG8_STAGE(bufoff, gbase, voff) do { _Pragma("unroll") for (int _i = 0; _i < 2; ++_i) \
        __builtin_amdgcn_global_load_lds((const unsigned*)((const char*)(gbase) + (voff)[_i]), (LAS unsigned*)(lds + (bufoff) + ldsw + _i * 8192), 16, 0, 0); } while (0)
#define PG8_LDA(dst, b, h) do { _Pragma("unroll") for (int m = 0; m < 4; ++m) _Pragma("unroll") for (int k = 0; k < 2; ++k) dst[m][k] = *(const LAS bf16x8*)(lds + PG8_SA(b, h) + aoff + m * 2048 + k * 1024); } while (0)
#define PG8_LDB(dst, b, h) do { _Pragma("unroll") for (int n = 0; n < 2; ++n) _Pragma("unroll") for (int k = 0; k < 2; ++k) dst[n][k] = *(const LAS bf16x8*)(lds + PG8_SB(b, h) + boff + n * 2048 + k * 1024); } while (0)
#define PG8_MMA(ai, bj, At, Bt) do { __builtin_amdgcn_s_setprio(1); _Pragma("unroll") for (int m = 0; m < 4; ++m) _Pragma("unroll") for (int n = 0; n < 2; ++n) _Pragma("unroll") for (int k = 0; k < 2; ++k) \
        acc[ai][bj][m][n] = __builtin_amdgcn_mfma_f32_16x16x32_bf16(Bt[n][k], At[m][k], acc[ai][bj][m][n], 0, 0, 0); __builtin_amdgcn_s_setprio(0); } while (0)
#define PG8_WAIT_V(n) asm volatile("s_waitcnt vmcnt(" #n ")" ::: "memory")
#define PG8_WAIT_L(n) asm volatile("s_waitcnt lgkmcnt(" #n ")" ::: "memory")
#define PG8_BAR __builtin_amdgcn_s_barrier()
#define PG8_SCHED __builtin_amdgcn_sched_barrier(0)
    Unit cur, nxt; int ui = 0;
    LAS float* rsl = (LAS float*)(lds + LDS_RS_OFF);
    if (E.rs) { Unit uu; for (int i = 0; i < LDS_RS_UNITS && S.next(i, uu); ++i) if (tid < 256) rsl[i * 256 + tid] = E.rs[uu.pm * BM + tid]; }
    __syncthreads();
    if (!S.next(0, cur)) return;
    f32x4 acc[2][2][4][2];
#pragma unroll
    for (int a = 0; a < 2; ++a)
#pragma unroll
        for (int b = 0; b < 2; ++b)
#pragma unroll
            for (int m = 0; m < 4; ++m)
#pragma unroll
                for (int n = 0; n < 2; ++n) acc[a][b][m][n] = (f32x4){0.f, 0.f, 0.f, 0.f};
    bf16x8 At[4][2], B0[2][2], B1[2][2];
    const char* cA = (const char*)g.A + (size_t)cur.pm * tstep; const char* cB = (const char*)g.Bt + (size_t)cur.pn * tstep;
    PG8_STAGE(PG8_SB(0, 0), cB, voffB); PG8_STAGE(PG8_SA(0, 0), cA, voffA); PG8_STAGE(PG8_SB(0, 1), cB + hstep, voffB); PG8_STAGE(PG8_SA(0, 1), cA + hstep, voffA);
    if (wr == 1) PG8_BAR;
    PG8_WAIT_V(4); PG8_BAR;
    PG8_STAGE(PG8_SB(1, 0), cB + kstep, voffB); PG8_STAGE(PG8_SA(1, 0), cA + kstep, voffA); PG8_STAGE(PG8_SB(1, 1), cB + hstep + kstep, voffB);
    PG8_WAIT_V(6); PG8_BAR;
    for (;;) {
        const bool has_next = S.next(ui + 1, nxt);
        const char* nA = has_next ? (const char*)g.A + (size_t)nxt.pm * tstep : cA; const char* nB = has_next ? (const char*)g.Bt + (size_t)nxt.pn * tstep : cB;
        for (int t = 0; t < nt; t += 2) {
            const bool last = (t == nt - 2);
            const char* a1 = cA + (size_t)(t + 1) * kstep;
            const char* a2 = last ? nA : cA + (size_t)(t + 2) * kstep; const char* b2 = last ? nB : cB + (size_t)(t + 2) * kstep;
            const char* a3 = a2 + kstep; const char* b3 = b2 + kstep;
            PG8_LDB(B0, 0, 0); PG8_SCHED; PG8_LDA(At, 0, 0); PG8_STAGE(PG8_SA(1, 1), a1 + hstep, voffA);
            PG8_WAIT_L(8); PG8_BAR; PG8_WAIT_L(0); PG8_MMA(0, 0, At, B0); PG8_BAR; PG8_SCHED;
            PG8_LDB(B1, 0, 1); PG8_STAGE(PG8_SB(0, 0), b2, voffB);
            PG8_BAR; PG8_WAIT_L(0); PG8_MMA(0, 1, At, B1); PG8_BAR;
            PG8_LDA(At, 0, 1); PG8_STAGE(PG8_SA(0, 0), a2, voffA);
            PG8_BAR; PG8_WAIT_L(0); PG8_MMA(1, 0, At, B0); PG8_BAR; PG8_SCHED;
            PG8_STAGE(PG8_SB(0, 1), b2 + hstep, voffB);
            PG8_WAIT_V(6); PG8_BAR; PG8_MMA(1, 1, At, B1); PG8_BAR;
            PG8_LDB(B0, 1, 0); PG8_SCHED; PG8_LDA(At, 1, 0); PG8_STAGE(PG8_SA(0, 1), a2 + hstep, voffA);
            PG8_WAIT_L(8); PG8_BAR; PG8_WAIT_L(0); PG8_MMA(0, 0, At, B0); PG8_BAR; PG8_SCHED;
            PG8_LDB(B1, 1, 1); PG8_STAGE(PG8_SB(1, 0), b3, voffB);
            PG8_BAR; PG8_WAIT_L(0); PG8_MMA(0, 1, At, B1); PG8_BAR;
            PG8_LDA(At, 1, 1); PG8_STAGE(PG8_SA(1, 0), a3, voffA);
            PG8_BAR; PG8_WAIT_L(0); PG8_MMA(1, 0, At, B0); PG8_BAR; PG8_SCHED;
            PG8_STAGE(PG8_SB(1, 1), b3 + hstep, voffB);
            PG8_WAIT_V(6); PG8_BAR; PG8_MMA(1, 1, At, B1); PG8_BAR;
        }
        E(acc, cur, wr, wc, fr, fq, rsl + ui * 256);
        if (!has_next) break;
#pragma unroll
        for (int a = 0; a < 2; ++a)
#pragma unroll
            for (int b = 0; b < 2; ++b)
#pragma unroll
                for (int m = 0; m < 4; ++m)
#pragma unroll
                    for (int n = 0; n < 2; ++n) acc[a][b][m][n] = (f32x4){0.f, 0.f, 0.f, 0.f};
        cur = nxt; cA = nA; cB = nB; ++ui;
    }
    PG8_WAIT_V(0);
    if (wr == 0) PG8_BAR;
    PG8_BAR;
#undef PG8_SA
#undef PG8_SB
#undef PG8_STAGE
#undef PG8_LDA
#undef PG8_LDB
#undef PG8_MMA
#undef PG8_WAIT_V
#undef PG8_WAIT_L
#undef PG8_BAR
#undef PG8_SCHED
}
}

__device__ __forceinline__ void skinny16(LAS unsigned char* lds, const bf16_t* A, int K, const bf16_t* Bt, int ntiles, int mode, bf16_t* O, int ldo, const float* rs, const int tid, const int bid) {
    const int wid = __builtin_amdgcn_readfirstlane(tid >> 6), lane = tid & 63, fr = lane & 15, fq = lane >> 4;
    LAS f32x4* RED = (LAS f32x4*)lds;
    const int nsteps = K / 32;
    for (int tile = (int)gridDim.x - 1 - bid; tile < ntiles; tile += gridDim.x) {
        const int c0 = 16 * tile, rb0 = mode ? ((c0 >> 7) * 256 + (c0 & 127)) : c0;
        f32x4 acc0 = (f32x4){0.f, 0.f, 0.f, 0.f}, acc1 = (f32x4){0.f, 0.f, 0.f, 0.f};
        const bf16_t* ap = A + (size_t)fr * K + fq * 8;
        const bf16_t* bp0 = Bt + (size_t)(rb0 + fr) * K + fq * 8;
        const bf16_t* bp1 = bp0 + (size_t)128 * K;
        for (int s = wid; s < nsteps; s += 32) {
            bf16x8 a[4], b0[4], b1[4];
#pragma unroll
            for (int j = 0; j < 4; ++j) { const int sj = s + 8 * j, sc = sj < nsteps ? sj : s;
                a[j] = *(const bf16x8*)(ap + sc * 32); b0[j] = *(const bf16x8*)(bp0 + sc * 32); if (mode) b1[j] = *(const bf16x8*)(bp1 + sc * 32); }
#pragma unroll
            for (int j = 0; j < 4; ++j) if (s + 8 * j < nsteps) {
                acc0 = __builtin_amdgcn_mfma_f32_16x16x32_bf16(b0[j], a[j], acc0, 0, 0, 0);
                if (mode) acc1 = __builtin_amdgcn_mfma_f32_16x16x32_bf16(b1[j], a[j], acc1, 0, 0, 0); }
        }
        RED[(wid * 2 + 0) * 64 + lane] = acc0; RED[(wid * 2 + 1) * 64 + lane] = acc1;
        __syncthreads();
        if (wid == 0) {
            f32x4 s0 = (f32x4){0.f, 0.f, 0.f, 0.f}, s1 = s0;
#pragma unroll
            for (int w = 0; w < 8; ++w) { s0 += RED[(w * 2 + 0) * 64 + lane]; s1 += RED[(w * 2 + 1) * 64 + lane]; }
            if (rs) { const float sc = rs[fr]; s0 *= sc; s1 *= sc; }
            if (mode) {
#pragma unroll
                for (int j = 0; j < 4; ++j) s0[j] = silu_f(s0[j]) * s1[j];
            }
            u32x2 w; w.x = cvt_pk_bf16(s0[0], s0[1]); w.y = cvt_pk_bf16(s0[2], s0[3]);
            *(u32x2*)(O + (size_t)fr * ldo + c0 + 4 * fq) = w;
        }
        __syncthreads();
    }
}

struct TileDesc { const float* src; bf16_t* dst; const float* g; int N, K; };
__device__ __forceinline__ TileDesc decode_tile(const Params& p, int g) {
    const float* W; bf16_t* out; const float* gn = nullptr; int K, N, mode, loc;
    if (g < 688)       { W = p.in[3];  out = (bf16_t*)(p.ws + WS_W1A); K = D;   N = DFF;  mode = 1; loc = g; gn = p.in[2]; }
    else if (g < 1376) { W = p.in[4];  out = (bf16_t*)(p.ws + WS_W1A); K = D;   N = DFF;  mode = 2; loc = g - 688; gn = p.in[2]; }
    else if (g < 2064) { W = p.in[5];  out = (bf16_t*)(p.ws + WS_W1B); K = DFF; N = D;    mode = 0; loc = g - 1376; }
    else if (g < 2704) { W = p.in[8];  out = (bf16_t*)(p.ws + WS_WIN); K = D;   N = NINC; mode = 0; loc = g - 2064; gn = p.in[7]; }
    else if (g < 2960) { W = p.in[19]; out = (bf16_t*)(p.ws + WS_WOUT); K = D;  N = D;    mode = 0; loc = g - 2704; }
    else if (g < 3648) { W = p.in[22]; out = (bf16_t*)(p.ws + WS_W2A); K = D;   N = DFF;  mode = 1; loc = g - 2960; gn = p.in[21]; }
    else if (g < 4336) { W = p.in[23]; out = (bf16_t*)(p.ws + WS_W2A); K = D;   N = DFF;  mode = 2; loc = g - 3648; gn = p.in[21]; }
    else               { W = p.in[24]; out = (bf16_t*)(p.ws + WS_W2B); K = DFF; N = D;    mode = 0; loc = g - 4336; }
    const int nNt = N / 128, kt = loc / nNt, ntl = loc % nNt;
    const int rowbase = mode == 0 ? ntl * 128 : ntl * 256 + (mode == 2 ? 128 : 0);
    TileDesc t; t.src = W + (size_t)(kt * 128) * N + ntl * 128; t.dst = out + (size_t)rowbase * K + kt * 128; t.g = gn ? gn + kt * 128 : nullptr; t.N = N; t.K = K; return t;
}
constexpr int PREP_TILES = 5024;
__device__ __forceinline__ void prep_weights(const Params& p, LAS unsigned char* lds, const int tid, const int bid) {
    LAS float* T = (LAS float*)lds;
    const int r = tid >> 5, c4 = tid & 31;
    int g = bid;
    if (g >= PREP_TILES) return;
    TileDesc td = decode_tile(p, g);
    f32x4 v[8];
#pragma unroll
    for (int i = 0; i < 8; ++i) v[i] = *(const f32x4*)(td.src + (size_t)(r + 16 * i) * td.N + 4 * c4);
    for (;;) {
#pragma unroll
        for (int i = 0; i < 8; ++i) { const int k = r + 16 * i; *(LAS f32x4*)(T + k * 132 + 4 * (c4 ^ ((k >> 3) & 7))) = v[i]; }
        __syncthreads();
        const int gn = g + gridDim.x; const bool has_next = gn < PREP_TILES;
        TileDesc tn = td;
        if (has_next) { tn = decode_tile(p, gn);
#pragma unroll
            for (int i = 0; i < 8; ++i) v[i] = *(const f32x4*)(tn.src + (size_t)(r + 16 * i) * tn.N + 4 * c4); }
#pragma unroll
        for (int p2 = 0; p2 < 4; ++p2) { const int cch = tid & 15, nn = (tid >> 4) + 32 * p2, k8 = 8 * cch, ncol = nn ^ (4 * (cch & 7)); float x[8];
#pragma unroll
            for (int i = 0; i < 8; ++i) x[i] = T[(k8 + i) * 132 + ncol];
            if (td.g) { const f32x4 g0 = *(const f32x4*)(td.g + k8), g1 = *(const f32x4*)(td.g + k8 + 4);
                x[0] *= g0[0]; x[1] *= g0[1]; x[2] *= g0[2]; x[3] *= g0[3]; x[4] *= g1[0]; x[5] *= g1[1]; x[6] *= g1[2]; x[7] *= g1[3]; }
            u32x4 w; w.x = cvt_pk_bf16(x[0], x[1]); w.y = cvt_pk_bf16(x[2], x[3]); w.z = cvt_pk_bf16(x[4], x[5]); w.w = cvt_pk_bf16(x[6], x[7]);
            *(u32x4*)(td.dst + (size_t)nn * td.K + k8) = w; }
        __syncthreads();
        if (!has_next) break;
        g = gn; td = tn;
    }
}

__device__ __forceinline__ void ew_phase(const bf16_t* F, float coef, const float* gpost, const float* hx, const float* meta, const bf16_t* hb, float* out32, bf16_t* hbo, float* rso, int nrows, const int tid, const int bid) {
    const int lane = tid & 63, gw = bid * 8 + (tid >> 6), nw = gridDim.x * 8;
    for (int r0 = gw; r0 < nrows; r0 += 2 * nw) {
        int rr[2]; rr[0] = r0; rr[1] = (r0 + nw < nrows) ? r0 + nw : r0;
        f32x4 h[2][8]; u32x2 fw[2][8];
#pragma unroll
        for (int q = 0; q < 2; ++q) { const int r = rr[q];
            if (hx) { const float* hp = r < MX ? hx + (size_t)r * D : meta + (size_t)(r - MX) * D;
#pragma unroll
                for (int i = 0; i < 8; ++i) h[q][i] = *(const f32x4*)(hp + i * 256 + lane * 4); }
            else {
#pragma unroll
                for (int i = 0; i < 8; ++i) { const u32x2 w = *(const u32x2*)(hb + (size_t)r * D + i * 256 + lane * 4); h[q][i] = (f32x4){bflo(w.x), bfhi(w.x), bflo(w.y), bfhi(w.y)}; } }
            if (F) {
#pragma unroll
                for (int i = 0; i < 8; ++i) fw[q][i] = *(const u32x2*)(F + (size_t)r * D + i * 256 + lane * 4); } }
#pragma unroll
        for (int q = 0; q < 2; ++q) { const int r = rr[q];
            if (F) {
                f32x4 f[8]; float ss = 0.f;
#pragma unroll
                for (int i = 0; i < 8; ++i) { const u32x2 w = fw[q][i]; f[i] = (f32x4){bflo(w.x), bfhi(w.x), bflo(w.y), bfhi(w.y)}; ss += (f[i][0] * f[i][0] + f[i][1] * f[i][1]) + (f[i][2] * f[i][2] + f[i][3] * f[i][3]); }
                ss = wave64_sum(ss);
                const float rs = coef * rsqrtf(ss * (1.0f / D) + EPS);
#pragma unroll
                for (int i = 0; i < 8; ++i) { const f32x4 g = *(const f32x4*)(gpost + i * 256 + lane * 4); h[q][i] += f[i] * rs * g; }
            }
            if (out32 && r < MX) {
#pragma unroll
                for (int i = 0; i < 8; ++i) *(f32x4*)(out32 + (size_t)r * D + i * 256 + lane * 4) = h[q][i];
            }
            if (hbo) {
                float ss = 0.f;
#pragma unroll
                for (int i = 0; i < 8; ++i) ss += (h[q][i][0] * h[q][i][0] + h[q][i][1] * h[q][i][1]) + (h[q][i][2] * h[q][i][2] + h[q][i][3] * h[q][i][3]);
                ss = wave64_sum(ss);
                if (lane == 0) rso[r] = rsqrtf(ss * (1.0f / D) + EPS);
#pragma unroll
                for (int i = 0; i < 8; ++i) { u32x2 w; w.x = cvt_pk_bf16(h[q][i][0], h[q][i][1]); w.y = cvt_pk_bf16(h[q][i][2], h[q][i][3]);
                    *(u32x2*)(hbo + (size_t)r * D + i * 256 + lane * 4) = w; }
            }
        }
    }
}

constexpr int L_XIN = 0, L_XC = 17152, L_AA = L_XC + 16640, L_UU = L_AA + 16640, L_XCB = L_UU + 16640, L_WA = L_XCB + 9216, L_WX = L_WA + 9216, L_PART = L_WX + 9216, L_END = L_PART + 4096;
static_assert(L_END <= LDS_MAIN, "mixer LDS");
constexpr int NRUN = 16;
struct HeadConst { float cw0, cw1, cw2, cw3, cb, go; float sp[8], ba[8], bx[8]; };
__device__ __forceinline__ void lru_load_head(const Params& p, LAS unsigned char* lds, int h, const int tid, HeadConst& hc) {
    LAS bf16_t* WA = (LAS bf16_t*)(lds + L_WA); LAS bf16_t* WX = (LAS bf16_t*)(lds + L_WX);
    const float* wa = p.in[11] + (size_t)h * 4096; const float* wx = p.in[13] + (size_t)h * 4096;
    for (int e = tid; e < 4096; e += 512) { const int i = e >> 6, j = e & 63; WA[j * 72 + i] = f2bf(wa[e]); WX[j * 72 + i] = f2bf(wx[e]); }
    const int lane = tid & 63, wid = tid >> 6, fq = lane >> 4, nh = wid >> 2, ch = 64 * h + lane;
    hc.cw0 = p.in[9][ch]; hc.cw1 = p.in[9][DL + ch]; hc.cw2 = p.in[9][2 * DL + ch]; hc.cw3 = p.in[9][3 * DL + ch]; hc.cb = p.in[10][ch]; hc.go = p.in[17][ch];
#pragma unroll
    for (int k = 0; k < 8; ++k) { const int c2 = 64 * h + 16 * (2 * nh + (k >> 2)) + 4 * fq + (k & 3);
        hc.sp[k] = -8.0f * log1pf(__expf(-p.in[15][c2])); hc.ba[k] = p.in[12][c2]; hc.bx[k] = p.in[14][c2]; }
}
struct XinRegs { u32x4 a, b; };
__device__ __forceinline__ void xin_prefetch(const bf16_t* Z, int b, int h, int v, const int tid, XinRegs& x) {
    const int s0 = v < 0 ? 0 : NMETA + 64 * v, ntok = v < 0 ? NMETA : 64;
    x.a = (u32x4){0u, 0u, 0u, 0u}; x.b = x.a;
    { const int row = tid >> 3, seg = tid & 7, s = s0 - 3 + row; if (s >= 0 && row < ntok + 3) x.a = *(const u32x4*)(Z + (size_t)zrow(b, s) * NINC + DL + 64 * h + 8 * seg); }
    if (tid < 24) { const int e = 512 + tid, row = e >> 3, seg = e & 7, s = s0 - 3 + row; if (s >= 0 && row < ntok + 3) x.b = *(const u32x4*)(Z + (size_t)zrow(b, s) * NINC + DL + 64 * h + 8 * seg); }
}
__device__ __forceinline__ void xin_store(LAS float* XIN, const int tid, const XinRegs& x) {
    { LAS float* d = XIN + tid * 8; *(LAS f32x4*)d = (f32x4){bflo(x.a.x), bfhi(x.a.x), bflo(x.a.y), bfhi(x.a.y)}; *(LAS f32x4*)(d + 4) = (f32x4){bflo(x.a.z), bfhi(x.a.z), bflo(x.a.w), bfhi(x.a.w)}; }
    if (tid < 24) { LAS float* d = XIN + (512 + tid) * 8; *(LAS f32x4*)d = (f32x4){bflo(x.b.x), bfhi(x.b.x), bflo(x.b.y), bfhi(x.b.y)}; *(LAS f32x4*)(d + 4) = (f32x4){bflo(x.b.z), bfhi(x.b.z), bflo(x.b.w), bfhi(x.b.w)}; }
}
__device__ __forceinline__ void lru_tile_math(LAS unsigned char* lds, const int tid, const HeadConst& hc) {
    const int wid = __builtin_amdgcn_readfirstlane(tid >> 6), lane = tid & 63, fr = lane & 15, fq = lane >> 4;
    LAS float* XIN = (LAS float*)(lds + L_XIN); LAS float* XC = (LAS float*)(lds + L_XC); LAS float* AA = (LAS float*)(lds + L_AA); LAS float* UU = (LAS float*)(lds + L_UU);
    LAS bf16_t* XCB = (LAS bf16_t*)(lds + L_XCB); LAS bf16_t* WA = (LAS bf16_t*)(lds + L_WA); LAS bf16_t* WX = (LAS bf16_t*)(lds + L_WX);
    { const int c = lane;
#pragma unroll
      for (int q = 0; q < 8; ++q) { const int t = wid + 8 * q;
          const float xc = hc.cb + hc.cw0 * XIN[t * 64 + c] + hc.cw1 * XIN[(t + 1) * 64 + c] + hc.cw2 * XIN[(t + 2) * 64 + c] + hc.cw3 * XIN[(t + 3) * 64 + c];
          XC[t * 65 + c] = xc; XCB[t * 72 + c] = f2bf(xc); } }
    __syncthreads();
    { const int mt = wid & 3, nh = wid >> 2, tok = 16 * mt + fr;
#pragma unroll
      for (int nbi = 0; nbi < 2; ++nbi) { const int nb = 2 * nh + nbi;
          f32x4 ga = (f32x4){0.f, 0.f, 0.f, 0.f}, gx = ga;
#pragma unroll
          for (int ks = 0; ks < 2; ++ks) {
              const bf16x8 xf = *(const LAS bf16x8*)(XCB + tok * 72 + 32 * ks + 8 * fq);
              const bf16x8 waf = *(const LAS bf16x8*)(WA + (16 * nb + fr) * 72 + 32 * ks + 8 * fq);
              const bf16x8 wxf = *(const LAS bf16x8*)(WX + (16 * nb + fr) * 72 + 32 * ks + 8 * fq);
              ga = __builtin_amdgcn_mfma_f32_16x16x32_bf16(waf, xf, ga, 0, 0, 0);
              gx = __builtin_amdgcn_mfma_f32_16x16x32_bf16(wxf, xf, gx, 0, 0, 0); }
#pragma unroll
          for (int r = 0; r < 4; ++r) { const int col = 16 * nb + 4 * fq + r, k = nbi * 4 + r;
              const float a_g = __builtin_amdgcn_rcpf(1.0f + __expf(-(ga[r] + hc.ba[k]))), x_g = __builtin_amdgcn_rcpf(1.0f + __expf(-(gx[r] + hc.bx[k])));
              const float la = a_g * hc.sp[k];
              const float a = __expf(la), x2 = 2.0f * la;
              const float ser = -x2 * (1.0f + x2 * (0.5f + x2 * (0.16666667f + x2 * (0.041666668f + x2 * (0.0083333338f + x2 * 0.0013888889f)))));
              const float om = x2 > -0.25f ? ser : 1.0f - a * a;
              AA[tok * 65 + col] = a; UU[tok * 65 + col] = __builtin_amdgcn_sqrtf(om) * x_g * XC[tok * 65 + col]; } } }
    __syncthreads();
}
__device__ __forceinline__ void mixer_lru_scan(const Params& p, LAS unsigned char* lds, const int tid, const int bid) {
    const int wid = __builtin_amdgcn_readfirstlane(tid >> 6), lane = tid & 63;
    LAS float* XIN = (LAS float*)(lds + L_XIN); LAS float* AA = (LAS float*)(lds + L_AA); LAS float* UU = (LAS float*)(lds + L_UU); LAS float* PART = (LAS float*)(lds + L_PART);
    float* RSA = (float*)(p.ws + WS_SUMA); float* RSH = (float*)(p.ws + WS_SUMH);
    const bf16_t* Z = (const bf16_t*)(p.ws + WS_Z); unsigned* HP = (unsigned*)(p.ws + WS_F);
    int hl = -1; HeadConst hc;
    for (int it = bid; it < NBATCH * 16 * NRUN; it += gridDim.x) {
        const int h = it & 15, b = it >> 8, run = ((it >> 4) + b) & 15, ch = 64 * h + lane;
        if (h != hl) { lru_load_head(p, lds, h, tid, hc); hl = h; }
        const int v0 = run == 0 ? -1 : 4 * run, v1 = 4 * run + 4;
        float cinH = 0.f, cinA = 1.f;
        XinRegs xr; xin_prefetch(Z, b, h, v0, tid, xr);
        for (int v = v0; v < v1; ++v) {
            const int ntok = v < 0 ? NMETA : 64;
            xin_store(XIN, tid, xr);
            __syncthreads();
            if (v + 1 < v1) xin_prefetch(Z, b, h, v + 1, tid, xr);
            lru_tile_math(lds, tid, hc);
            float a[8], u[8]; float A = 1.f, H = 0.f;
#pragma unroll
            for (int i = 0; i < 8; ++i) { const int t = 8 * wid + i; a[i] = AA[t * 65 + lane]; u[i] = UU[t * 65 + lane]; if (t < ntok) { H = a[i] * H + u[i]; A *= a[i]; } }
            PART[(wid * 2 + 0) * 64 + lane] = A; PART[(wid * 2 + 1) * 64 + lane] = H;
            __syncthreads();
            float hcur = cinH, pcur = cinA;
#pragma unroll
            for (int w = 0; w < 8; ++w) { const float pa = PART[(w * 2 + 0) * 64 + lane], ph = PART[(w * 2 + 1) * 64 + lane]; cinH = pa * cinH + ph; cinA *= pa; if (w < wid) { hcur = pa * hcur + ph; pcur *= pa; } }
            if (v >= 0) {
                unsigned* hp = HP + ((size_t)b * SEQ + 64 * v + 8 * wid) * DL + ch;
#pragma unroll
                for (int i = 0; i < 8; ++i) { hcur = a[i] * hcur + u[i]; pcur *= a[i]; hp[(size_t)i * DL] = cvt_pk_bf16(hcur, pcur); }
            }
        }
        if (wid == 0) { RSA[(size_t)(b * NRUN + run) * DL + ch] = cinA; RSH[(size_t)(b * NRUN + run) * DL + ch] = cinH; }
    }
}
__device__ __forceinline__ void mixer_lru_out(const Params& p, const int tid, const int bid) {
    const int wid = tid >> 6, lane = tid & 63;
    const float* RSA = (const float*)(p.ws + WS_SUMA); const float* RSH = (const float*)(p.ws + WS_SUMH);
    const bf16_t* Z = (const bf16_t*)(p.ws + WS_Z); const unsigned* HP = (const unsigned*)(p.ws + WS_F); bf16_t* MIX = (bf16_t*)p.out;
    for (int wi = bid * 8 + wid; wi < NBATCH * NRUN * 8 * 4; wi += gridDim.x * 8) {
        const int q = wi & 3, chunk = (wi >> 2) & 7, run = (wi >> 5) & 15, b = wi >> 9, col = 256 * q + 4 * lane;
        f32x4 cin = (f32x4){0.f, 0.f, 0.f, 0.f};
        { f32x4 sa[NRUN - 1], sh[NRUN - 1];
#pragma unroll
          for (int rr = 0; rr < NRUN - 1; ++rr) { const size_t o = (size_t)(b * NRUN + (rr < run ? rr : 0)) * DL + col; sa[rr] = *(const f32x4*)(RSA + o); sh[rr] = *(const f32x4*)(RSH + o); }
#pragma unroll
          for (int rr = 0; rr < NRUN - 1; ++rr) if (rr < run) cin = sa[rr] * cin + sh[rr]; }
        const f32x4 go = *(const f32x4*)(p.in[17] + col);
        const size_t row0 = (size_t)b * SEQ + 256 * run + 32 * chunk;
#pragma unroll 8
        for (int i = 0; i < 32; ++i) { const size_t row = row0 + i;
            const u32x4 hp = *(const u32x4*)(HP + row * DL + col);
            const u32x2 yw = *(const u32x2*)(Z + row * NINC + col);
            const f32x4 hh = (f32x4){bflo(hp.x) + bfhi(hp.x) * cin[0], bflo(hp.y) + bfhi(hp.y) * cin[1], bflo(hp.z) + bfhi(hp.z) * cin[2], bflo(hp.w) + bfhi(hp.w) * cin[3]};
            const f32x4 y = (f32x4){bflo(yw.x), bfhi(yw.x), bflo(yw.y), bfhi(yw.y)};
            f32x4 vv;
#pragma unroll
            for (int k = 0; k < 4; ++k) { const float z2 = y[k] * (1.5957691216057308f + 0.07135481627f * y[k] * y[k]);
                vv[k] = hh[k] * y[k] * __builtin_amdgcn_rcpf(1.0f + __expf(-z2)); }
            const float ss = row16_sum((vv[0] * vv[0] + vv[1] * vv[1]) + (vv[2] * vv[2] + vv[3] * vv[3]));
            const f32x4 r = vv * __builtin_amdgcn_rsqf(ss * (1.0f / 64.0f) + EPS) * go;
            u32x2 w; w.x = cvt_pk_bf16(r[0], r[1]); w.y = cvt_pk_bf16(r[2], r[3]);
            *(u32x2*)(MIX + row * D + col) = w; }
    }
}
__device__ __forceinline__ void mixer_sconv(const Params& p, const int tid, const int bid) {
    const int wid = tid >> 6, lane = tid & 63;
    const bf16_t* Z = (const bf16_t*)(p.ws + WS_Z); bf16_t* MIX = (bf16_t*)p.out;
    for (int wi = bid * 8 + wid; wi < NBATCH * 128 * 4; wi += gridDim.x * 8) {
        const int q = wi & 3, c32 = (wi >> 2) & 127, b = wi >> 9, col = 256 * q + 4 * lane;
        const f32x4 w0 = *(const f32x4*)(p.in[16] + col), w1 = *(const f32x4*)(p.in[16] + DL + col), w2 = *(const f32x4*)(p.in[16] + 2 * DL + col), gg = *(const f32x4*)(p.in[18] + col);
        const int t0 = 32 * c32, s = NMETA + t0;
        f32x4 cvm2, cvm1;
        { const size_t r2 = (size_t)zrow(b, s - 2) * NINC + col, r1 = (size_t)zrow(b, s - 1) * NINC + col;
          const u32x2 c2 = *(const u32x2*)(Z + r2 + 3 * DL), v2 = *(const u32x2*)(Z + r2 + 4 * DL), c1 = *(const u32x2*)(Z + r1 + 3 * DL), v1 = *(const u32x2*)(Z + r1 + 4 * DL);
          cvm2 = (f32x4){bflo(c2.x) * bflo(v2.x), bfhi(c2.x) * bfhi(v2.x), bflo(c2.y) * bflo(v2.y), bfhi(c2.y) * bfhi(v2.y)};
          cvm1 = (f32x4){bflo(c1.x) * bflo(v1.x), bfhi(c1.x) * bfhi(v1.x), bflo(c1.y) * bflo(v1.y), bfhi(c1.y) * bfhi(v1.y)}; }
#pragma unroll 8
        for (int i = 0; i < 32; ++i) { const size_t row = (size_t)b * SEQ + t0 + i; const size_t zr = row * NINC + col;
            const u32x2 cw = *(const u32x2*)(Z + zr + 3 * DL), vw = *(const u32x2*)(Z + zr + 4 * DL), bw = *(const u32x2*)(Z + zr + 2 * DL);
            const f32x4 cv0 = (f32x4){bflo(cw.x) * bflo(vw.x), bfhi(cw.x) * bfhi(vw.x), bflo(cw.y) * bflo(vw.y), bfhi(cw.y) * bfhi(vw.y)};
            const f32x4 bs = (f32x4){bflo(bw.x), bfhi(bw.x), bflo(bw.y), bfhi(bw.y)};
            const f32x4 o = bs * (w0 * cvm2 + w1 * cvm1 + w2 * cv0);
            const float ss = row16_sum((o[0] * o[0] + o[1] * o[1]) + (o[2] * o[2] + o[3] * o[3]));
            const f32x4 r = o * (rsqrtf(ss * (1.0f / 64.0f) + EPS)) * gg;
            u32x2 w; w.x = cvt_pk_bf16(r[0], r[1]); w.y = cvt_pk_bf16(r[2], r[3]);
            *(u32x2*)(MIX + row * D + DL + col) = w;
            cvm2 = cvm1; cvm1 = cv0; }
    }
}

#define XB_TMO      128
#define XB_XCNT(j)  (256  + 64 * (j))
#define XB_XSUB(j)  (1280 + 64 * (j))
#define XB_XGEN(j)  (2304 + 64 * (j))
#define XB_TOP      3328
#define XB_TOPGEN   3392
#define XCD_BAR_WORDS 3456
#define XB_SPIN_CAP (1u << 20)
__device__ __forceinline__ unsigned xb_ld(unsigned* p)              { return __hip_atomic_load(p, __ATOMIC_RELAXED, __HIP_MEMORY_SCOPE_AGENT); }
__device__ __forceinline__ unsigned xb_add(unsigned* p, unsigned v) { return __hip_atomic_fetch_add(p, v, __ATOMIC_RELAXED, __HIP_MEMORY_SCOPE_AGENT); }
__device__ __forceinline__ unsigned xb_xcc_id() { return (unsigned)__builtin_amdgcn_s_getreg((3 << 11) | 20) & 0xFu; }
#define XB_SPIN(cond, bar) do { unsigned _sp = 0; while (cond) { __builtin_amdgcn_s_sleep(1); \
    if ((++_sp & 255u) == 0u) { if (xb_ld(&(bar)[XB_TMO])) break; if (_sp > XB_SPIN_CAP) { atomicAdd(&(bar)[XB_TMO], 1u); break; } } } } while (0)
struct XcdBarrier { unsigned* bar; unsigned x; volatile LAS unsigned* st; };
__device__ __forceinline__ XcdBarrier xcd_barrier_post(unsigned* bar, volatile LAS unsigned* st) {
    XcdBarrier b; b.bar = bar; b.x = xb_xcc_id(); b.st = st;
    if (threadIdx.x == 0) (void)xb_add(&bar[XB_XCNT(b.x)], 1u);
    return b;
}
__device__ __forceinline__ void xcd_barrier_complete(unsigned* bar, unsigned x, unsigned& nloc, unsigned& nx) {
    const unsigned G = gridDim.x * gridDim.y * gridDim.z;
    unsigned sum, cnt, mine, sp = 0u;
    for (;;) {
        sum = 0u; cnt = 0u; mine = 0u;
#pragma unroll
        for (unsigned j = 0; j < 16; ++j) { const unsigned c = xb_ld(&bar[XB_XCNT(j)]); sum += c; cnt += (c > 0u) ? 1u : 0u; mine = (j == x) ? c : mine; }
        if (sum == G) break;
        __builtin_amdgcn_s_sleep(1);
        if ((++sp & 255u) == 0u) { if (xb_ld(&bar[XB_TMO])) break; if (sp > XB_SPIN_CAP) { atomicAdd(&bar[XB_TMO], 1u); break; } }
    }
    nloc = mine > 0u ? mine : 1u; nx = cnt > 0u ? cnt : 1u;
}
__device__ __forceinline__ void xcd_barrier(const XcdBarrier& b) {
    asm volatile("s_waitcnt vmcnt(0)" ::: "memory");
    __syncthreads();
    if (threadIdx.x == 0) {
        unsigned* bar = b.bar;
        __builtin_amdgcn_s_waitcnt(0);
        unsigned nloc = b.st[0], nx = b.st[1];
        if (nloc == 0u) { xcd_barrier_complete(bar, b.x, nloc, nx); b.st[0] = nloc; b.st[1] = nx; }
        const unsigned old = xb_add(&bar[XB_XSUB(b.x)], 1u);
        const unsigned gen = old / nloc;
        if (old + 1u == (gen + 1u) * nloc) {
            __builtin_amdgcn_fence(__ATOMIC_RELEASE, "agent");
            asm volatile("s_waitcnt vmcnt(0)" ::: "memory");
            const unsigned og = xb_add(&bar[XB_TOP], 1u);
            const unsigned tg = og / nx;
            if (og + 1u == (tg + 1u) * nx) xb_add(&bar[XB_TOPGEN], 1u);
            else XB_SPIN(xb_ld(&bar[XB_TOPGEN]) == tg, bar);
            __builtin_amdgcn_fence(__ATOMIC_ACQUIRE, "agent");
            xb_add(&bar[XB_XGEN(b.x)], 1u);
            asm volatile("s_waitcnt vmcnt(0)" ::: "memory");
        } else {
            XB_SPIN(xb_ld(&bar[XB_XGEN(b.x)]) == gen, bar);
            __builtin_amdgcn_fence(__ATOMIC_ACQUIRE, "agent");
            asm volatile("s_waitcnt vmcnt(0)" ::: "memory");
        }
    }
    __syncthreads();
}

__global__ void __launch_bounds__(512, 2) fwd_kernel(Params p) {
    extern __shared__ __attribute__((aligned(16))) unsigned char lds_raw[];
    LAS unsigned char* lds = (LAS unsigned char*)lds_raw;
    cg::grid_group grid = cg::this_grid();
    volatile LAS unsigned* xst = (volatile LAS unsigned*)(lds + LDS_MAIN);
    if (threadIdx.x == 0) { xst[0] = 0u; xst[1] = 0u; }
    __syncthreads();
    const XcdBarrier xbar = xcd_barrier_post((unsigned*)(p.ws + WS_BAR), xst);
    if (p.ph_hi > NPHASE + 100) grid.sync();
    bf16_t* W1A = (bf16_t*)(p.ws + WS_W1A); bf16_t* W1B = (bf16_t*)(p.ws + WS_W1B); bf16_t* WIN = (bf16_t*)(p.ws + WS_WIN); bf16_t* WOUT = (bf16_t*)(p.ws + WS_WOUT);
    bf16_t* W2A = (bf16_t*)(p.ws + WS_W2A); bf16_t* W2B = (bf16_t*)(p.ws + WS_W2B);
    bf16_t* HB = (bf16_t*)(p.ws + WS_ABUF); bf16_t* MIXB = (bf16_t*)p.out; float* RS = (float*)(p.ws + WS_RS); bf16_t* ACT = (bf16_t*)(p.ws + WS_ACT); bf16_t* FB = (bf16_t*)(p.ws + WS_F); bf16_t* ZB = (bf16_t*)(p.ws + WS_Z);
    for (int ph = p.ph_lo; ph < p.ph_hi; ++ph) {
      const int nrep = ((REPMASK >> ph) & 1) ? 2 : 1;
      for (int rep = 0; rep < nrep; ++rep) {
        int tid = threadIdx.x, bid = blockIdx.x;
        asm volatile("" : "+v"(tid), "+s"(bid));
        if (ph == 0 && (PHMASK & 1)) {
            prep_weights(p, lds, tid, bid);
            ew_phase(nullptr, 0.f, nullptr, p.in[0], p.in[1], nullptr, nullptr, HB, RS, MROWS, tid, bid);
        } else if ((ph == 1 || ph == 9) && (PHMASK & 2)) {
            pg8::Gemm g{HB, ph == 1 ? W1A : W2A, MX, 2 * DFF, D}; pg8::StaticOrder S; S.init(MX, 2 * DFF, gridDim.x, bid);
            pg8::EpiSwiglu E{ACT, DFF, RS};
            pg8::gemm_phase<pg8::EpiSwiglu>(lds, g, S, E, tid);
            if (ph == 1) skinny16(lds, HB + (size_t)MX * D, D, W1A, DFF / 16, 1, ACT + (size_t)MX * DFF, DFF, RS + MX, tid, bid);
        } else if ((ph == 2 || ph == 4 || ph == 7 || ph == 10) && (PHMASK & 4)) {
            const bf16_t* A; const bf16_t* Bt; bf16_t* O; int N, K; const float* rs = nullptr;
            if (ph == 2)      { A = ACT;  Bt = W1B;  O = FB; N = D;    K = DFF; }
            else if (ph == 4) { A = HB;   Bt = WIN;  O = ZB; N = NINC; K = D; rs = RS; }
            else if (ph == 7) { A = MIXB; Bt = WOUT; O = FB; N = D;    K = D; }
            else              { A = ACT;  Bt = W2B;  O = FB; N = D;    K = DFF; }
            pg8::Gemm g{A, Bt, MX, N, K}; pg8::StaticOrder S; S.init(MX, N, gridDim.x, bid);
            pg8::EpiBf16 E{O, N, rs};
            pg8::gemm_phase<pg8::EpiBf16>(lds, g, S, E, tid);
            if (ph == 2 || ph == 4) skinny16(lds, A + (size_t)MX * K, K, Bt, N / 16, 0, O + (size_t)MX * N, N, rs ? rs + MX : nullptr, tid, bid);
        } else if (ph == 3 && (PHMASK & 8)) {
            ew_phase(FB, 0.5f, p.in[6], nullptr, nullptr, HB, nullptr, HB, RS, MROWS, tid, bid);
        } else if (ph == 5 && (PHMASK & 16)) {
            mixer_lru_scan(p, lds, tid, bid); mixer_sconv(p, tid, bid);
        } else if (ph == 6 && (PHMASK & 32)) {
            mixer_lru_out(p, tid, bid);
        } else if (ph == 8 && (PHMASK & 8)) {
            ew_phase(FB, 1.0f, p.in[20], nullptr, nullptr, HB, nullptr, HB, RS, MX, tid, bid);
        } else if (ph == 11 && (PHMASK & 8)) {
            ew_phase(FB, 0.5f, p.in[25], nullptr, nullptr, HB, p.out, nullptr, nullptr, MX, tid, bid);
        }
        if (ph + 1 < p.ph_hi || rep + 1 < nrep) xcd_barrier(xbar);
      }
    }
}

extern "C" void kernel_launch(void* const* d_in, const int* in_sizes, int n_in, void* d_out, int out_size, void* d_ws, size_t ws_size, hipStream_t stream) {
    static int grid = 0;
    if (grid == 0) {
        if (n_in != 26 || out_size != MX * D || ws_size < WS_END) { fprintf(stderr, "kernel_launch: unexpected shapes (n_in %d out %d ws %zu need %zu)\n", n_in, out_size, ws_size, (size_t)WS_END); grid = -1; return; }
        int dev = 0, cus = 0, per_cu = 0;
        hipGetDevice(&dev); hipDeviceGetAttribute(&cus, hipDeviceAttributeMultiprocessorCount, dev);
        if (hipFuncSetAttribute((const void*)fwd_kernel, hipFuncAttributeMaxDynamicSharedMemorySize, LDS_BYTES) != hipSuccess) { fprintf(stderr, "kernel_launch: hipFuncSetAttribute failed\n"); grid = -1; return; }
        if (hipOccupancyMaxActiveBlocksPerMultiprocessor(&per_cu, (const void*)fwd_kernel, 512, LDS_BYTES) != hipSuccess || per_cu < 1) { fprintf(stderr, "kernel_launch: occupancy query gave %d\n", per_cu); per_cu = 1; }
        (void)hipGetLastError();
        grid = cus * 1;
        fprintf(stderr, "kernel_launch: grid %d (cus %d, per_cu %d)\n", grid, cus, per_cu);
    }
    if (grid < 0) return;
    if (hipMemsetAsync((char*)d_ws + WS_BAR, 0, XCD_BAR_WORDS * 4, stream) != hipSuccess) { fprintf(stderr, "kernel_launch: memset of the barrier words failed\n"); return; }
    Params p{};
    for (int i = 0; i < 26; ++i) p.in[i] = (const float*)d_in[i];
    p.out = (float*)d_out; p.ws = (unsigned char*)d_ws;
#if ONE_LAUNCH
    p.ph_lo = 0; p.ph_hi = NPHASE;
    { void* args[] = {&p}; hipError_t e = hipLaunchCooperativeKernel((const void*)fwd_kernel, dim3(grid), dim3(512), args, LDS_BYTES, stream);
      if (e != hipSuccess) fprintf(stderr, "cooperative launch failed: %s\n", hipGetErrorString(e)); }
#else
    for (int ph = 0; ph < NPHASE; ++ph) {
        p.ph_lo = ph; p.ph_hi = ph + 1;
        void* args[] = {&p}; hipError_t e = hipLaunchCooperativeKernel((const void*)fwd_kernel, dim3(grid), dim3(512), args, LDS_BYTES, stream);
        if (e != hipSuccess) { fprintf(stderr, "cooperative launch %d failed: %s\n", ph, hipGetErrorString(e)); break; }
    }
#endif
}
```

```cpp
#include <hip/hip_runtime.h>
#include <hip/hip_cooperative_groups.h>
#include <cstdio>
namespace cg = cooperative_groups;

#ifndef PHMASK
#define PHMASK 0xFFF
#endif
#ifndef REPMASK
#define REPMASK 0
#endif
#ifndef ONE_LAUNCH
#define ONE_LAUNCH 1
#endif

#define LAS __attribute__((address_space(3)))
typedef unsigned short bf16_t;
typedef short bf16x8 __attribute__((ext_vector_type(8)));
typedef float f32x4 __attribute__((ext_vector_type(4)));
typedef unsigned u32x4 __attribute__((ext_vector_type(4)));
typedef unsigned u32x2 __attribute__((ext_vector_type(2)));

constexpr int D = 2048, DFF = 5504, DL = 1024, NINC = 5120, SEQ = 4096, NBATCH = 4, NMETA = 16;
constexpr int MX = NBATCH * SEQ;
constexpr int MROWS = MX + NMETA;
constexpr int NTILE = 65;
constexpr float EPS = 1e-6f;
constexpr int NPHASE = 12;
constexpr int LDS_MAIN = 131072, LDS_RS_OFF = LDS_MAIN + 64, LDS_RS_UNITS = 24, LDS_BYTES = LDS_RS_OFF + LDS_RS_UNITS * 1024;

constexpr size_t SZ_WA = (size_t)2 * DFF * D * 2, SZ_WB = (size_t)D * DFF * 2, SZ_WIN = (size_t)NINC * D * 2, SZ_WOUT = (size_t)D * D * 2;
constexpr size_t WS_W1A = 0, WS_W1B = WS_W1A + SZ_WA, WS_WIN = WS_W1B + SZ_WB, WS_WOUT = WS_WIN + SZ_WIN, WS_W2A = WS_WOUT + SZ_WOUT, WS_W2B = WS_W2A + SZ_WA;
constexpr size_t WS_ABUF = WS_W2B + SZ_WB;
constexpr size_t WS_ACT = WS_ABUF + (size_t)MROWS * D * 2;
constexpr size_t WS_F = WS_ACT + (size_t)MROWS * DFF * 2;
constexpr size_t WS_Z = WS_ACT;
constexpr size_t WS_SUMA = WS_F + (size_t)MROWS * D * 2;
constexpr size_t WS_SUMH = WS_SUMA + (size_t)NBATCH * NTILE * DL * 4;
constexpr size_t WS_BAR = WS_SUMH + (size_t)NBATCH * NTILE * DL * 4;
constexpr size_t WS_RS = WS_BAR + 16384;
constexpr size_t WS_END = WS_RS + 65792;
static_assert((size_t)MROWS * NINC * 2 <= (size_t)MROWS * DFF * 2 + (size_t)MROWS * D * 2, "Z must fit in ACT+F");

struct Params { const float* in[26]; float* out; unsigned char* ws; int ph_lo, ph_hi; };

__device__ __forceinline__ unsigned cvt_pk_bf16(float lo, float hi) { unsigned r; asm volatile("v_cvt_pk_bf16_f32 %0, %1, %2" : "=v"(r) : "v"(lo), "v"(hi)); return r; }
__device__ __forceinline__ bf16_t f2bf(float x) { return (bf16_t)(cvt_pk_bf16(x, 0.f) & 0xffffu); }
__device__ __forceinline__ float bf2f(bf16_t h) { return __uint_as_float(((unsigned)h) << 16); }
__device__ __forceinline__ float bflo(unsigned w) { return __uint_as_float(w << 16); }
__device__ __forceinline__ float bfhi(unsigned w) { return __uint_as_float(w & 0xffff0000u); }
__device__ __forceinline__ float wave_sum(float v) {
#pragma unroll
    for (int o = 32; o >= 1; o >>= 1) v += __shfl_xor(v, o);
    return v;
}
template <int CTRL> __device__ __forceinline__ float dpp_f(float v) { return __builtin_bit_cast(float, __builtin_amdgcn_update_dpp(0, __builtin_bit_cast(int, v), CTRL, 0xf, 0xf, true)); }
__device__ __forceinline__ float row16_sum(float v) {
    v += dpp_f<0xB1>(v); v += dpp_f<0x4E>(v); v += dpp_f<0x141>(v); v += dpp_f<0x140>(v); return v;
}
__device__ __forceinline__ float wave64_sum(float v) {
    const float r = row16_sum(v); const int ri = __builtin_bit_cast(int, r);
    return __builtin_bit_cast(float, __builtin_amdgcn_readlane(ri, 0)) + __builtin_bit_cast(float, __builtin_amdgcn_readlane(ri, 16)) + __builtin_bit_cast(float, __builtin_amdgcn_readlane(ri, 32)) + __builtin_bit_cast(float, __builtin_amdgcn_readlane(ri, 48));
}
__device__ __forceinline__ float silu_f(float g) { return g * __builtin_amdgcn_rcpf(1.0f + __expf(-g)); }
__device__ __forceinline__ float sigmoid_f(float g) { return 1.0f / (1.0f + __expf(-g)); }
__device__ __forceinline__ float gelu_tanh_f(float y) { const float t = tanhf(0.7978845608028654f * (y + 0.044715f * y * y * y)); return 0.5f * y * (1.0f + t); }
__device__ __forceinline__ int zrow(int b, int s) { return s < NMETA ? MX + s : b * SEQ + (s - NMETA); }

namespace pg8 {
constexpr int BM = 256, BK = 64, HALF = 128, HTB = HALF * BK * 2, STAGE_BYTES = 8 * HTB, NXCD = 8, WGM = 8;
__device__ __forceinline__ int lds_byte(int r, int c) { const int st = (r >> 4) * 2 + (c >> 5), rr = r & 15, cc = c & 31, ob = rr * 64 + cc * 2; return st * 1024 + (ob ^ (((ob >> 9) & 1) << 5)); }
__device__ __forceinline__ void stage_rc(int b, int& R, int& C) { const int st = b / 1024, sb = b % 1024, swz = sb ^ (((sb >> 9) & 1) << 5); R = (st >> 1) * 16 + swz / 64; C = (st & 1) * 32 + (swz % 64) / 2; }
__device__ __forceinline__ int perm32(int rho) { const int n = rho >> 4, i = rho & 15; return 8 * (i >> 2) + 4 * n + (i & 3); }
struct Unit { int pm, pn; };
struct Gemm { const bf16_t* A; const bf16_t* Bt; int M, N, K; };
struct StaticOrder {
    int nM, nN, nwg, G, c;
    __device__ void init(int M, int N, int G_, int c_) { nM = M / BM; nN = N / BM; nwg = nM * nN; G = G_; c = c_; }
    __device__ bool next(int i, Unit& u) const {
        const long L = (long)i * G + c; if (L >= nwg) return false;
        int wgid = (int)L; { const int q = nwg / NXCD, r = nwg % NXCD, xcd = wgid % NXCD, off = wgid / NXCD; wgid = (xcd < r ? xcd * (q + 1) : r * (q + 1) + (xcd - r) * q) + off; }
        const int nig = WGM * nN, gid = wgid / nig, fm = gid * WGM, gsz = (nM - fm) < WGM ? (nM - fm) : WGM;
        u.pm = fm + ((wgid % nig) % gsz); u.pn = (wgid % nig) / gsz; return true;
    }
};
struct EpiBf16 {
    static constexpr bool PERM = true;
    bf16_t* O; int ldc; const float* rs;
    __device__ __forceinline__ void operator()(const f32x4 (&acc)[2][2][4][2], const Unit& u, int wr, int wc, int fr, int fq, const LAS float* rsl) const {
        const int row0 = u.pm * BM + wr * 64 + fr, col0 = u.pn * BM + wc * 32 + 8 * fq;
#pragma unroll
        for (int ai = 0; ai < 2; ++ai)
#pragma unroll
            for (int m = 0; m < 4; ++m) { bf16_t* rowp = O + (size_t)(row0 + ai * HALF + m * 16) * ldc + col0; const float sc = rs ? rsl[wr * 64 + fr + ai * HALF + m * 16] : 1.0f;
#pragma unroll
                for (int bj = 0; bj < 2; ++bj) { const f32x4 v0 = acc[ai][bj][m][0] * sc, v1 = acc[ai][bj][m][1] * sc;
                    u32x4 w; w.x = cvt_pk_bf16(v0[0], v0[1]); w.y = cvt_pk_bf16(v0[2], v0[3]); w.z = cvt_pk_bf16(v1[0], v1[1]); w.w = cvt_pk_bf16(v1[2], v1[3]);
                    *(u32x4*)(rowp + bj * HALF) = w; } }
    }
};
struct EpiSwiglu {
    static constexpr bool PERM = true;
    bf16_t* O; int ldc; const float* rs;
    __device__ __forceinline__ void operator()(const f32x4 (&acc)[2][2][4][2], const Unit& u, int wr, int wc, int fr, int fq, const LAS float* rsl) const {
        const int row0 = u.pm * BM + wr * 64 + fr, col0 = u.pn * HALF + wc * 32 + 8 * fq;
#pragma unroll
        for (int ai = 0; ai < 2; ++ai)
#pragma unroll
            for (int m = 0; m < 4; ++m) { bf16_t* rowp = O + (size_t)(row0 + ai * HALF + m * 16) * ldc + col0;
                const float sc = rsl[wr * 64 + fr + ai * HALF + m * 16], k1 = -1.4426950408889634f * sc, sc2 = sc * sc;
                const f32x4 g0 = acc[ai][0][m][0], g1 = acc[ai][0][m][1], u0 = acc[ai][1][m][0], u1 = acc[ai][1][m][1];
                float v[8];
#pragma unroll
                for (int j = 0; j < 4; ++j) { v[j] = (g0[j] * u0[j]) * (sc2 * __builtin_amdgcn_rcpf(1.0f + __builtin_amdgcn_exp2f(g0[j] * k1)));
                                              v[4 + j] = (g1[j] * u1[j]) * (sc2 * __builtin_amdgcn_rcpf(1.0f + __builtin_amdgcn_exp2f(g1[j] * k1))); }
                u32x4 w; w.x = cvt_pk_bf16(v[0], v[1]); w.y = cvt_pk_bf16(v[2], v[3]); w.z = cvt_pk_bf16(v[4], v[5]); w.w = cvt_pk_bf16(v[6], v[7]);
                *(u32x4*)rowp = w; }
    }
};

template <class Epi>
__device__ __forceinline__ void gemm_phase(LAS unsigned char* lds, const Gemm g, const StaticOrder& S, const Epi& E, const int tid) {
    const int wid = __builtin_amdgcn_readfirstlane(tid >> 6), lane = tid & 63, wr = wid >> 2, wc = wid & 3, fr = lane & 15, fq = lane >> 4;
    const int K = g.K, nt = K / BK;
    unsigned voffA[2], voffB[2];
#pragma unroll
    for (int i = 0; i < 2; ++i) { int R, C; stage_rc(tid * 16 + i * 8192, R, C); const int Rb = Epi::PERM ? ((R & ~31) + perm32(R & 31)) : R;
        voffA[i] = (unsigned)(R * K + C) * 2u; voffB[i] = (unsigned)(Rb * K + C) * 2u; }
    const size_t kstep = (size_t)(BK * 2);
    const size_t hstep = (size_t)HALF * K * 2;
    const size_t tstep = 2 * hstep;
    const unsigned ldsw = (unsigned)wid * 1024u;
    const int aoff = lds_byte(wr * 64 + fr, fq * 8), boff = lds_byte(wc * 32 + fr, fq * 8);
#define PG8_SA(b, h) (((b) * 2 + (h)) * HTB)
#define PG8_SB(b, h) ((4 + (b) * 2 + (h)) * HTB)
#define PG8_STAGE(bufoff, gbase, voff) do { _Pragma("unroll") for (int _i = 0; _i < 2; ++_i) \
        __builtin_amdgcn_global_load_lds((const unsigned*)((const char*)(gbase) + (voff)[_i]), (LAS unsigned*)(lds + (bufoff) + ldsw + _i * 8192), 16, 0, 0); } while (0)
#define PG8_LDA(dst, b, h) do { _Pragma("unroll") for (int m = 0; m < 4; ++m) _Pragma("unroll") for (int k = 0; k < 2; ++k) dst[m][k] = *(const LAS bf16x8*)(lds + PG8_SA(b, h) + aoff + m * 2048 + k * 1024); } while (0)
#define PG8_LDB(dst, b, h) do { _Pragma("unroll") for (int n = 0; n < 2; ++n) _Pragma("unroll") for (int k = 0; k < 2; ++k) dst[n][k] = *(const LAS bf16x8*)(lds + PG8_SB(b, h) + boff + n * 2048 + k * 1024); } while (0)
#define PG8_MMA(ai, bj, At, Bt) do { __builtin_amdgcn_s_setprio(1); _Pragma("unroll") for (int m = 0; m < 4; ++m) _Pragma("unroll") for (int n = 0; n < 2; ++n) _Pragma("unroll") for (int k = 0; k < 2; ++k) \
        acc[ai][bj][m][n] = __builtin_amdgcn_mfma_f32_16x16x32_bf16(Bt[n][k], At[m][k], acc[ai][bj][m][n], 0, 0, 0); __builtin_amdgcn_s_setprio(0); } while (0)
#define PG8_WAIT_V(n) asm volatile("s_waitcnt vmcnt(" #n ")" ::: "memory")
#define PG8_WAIT_L(n) asm volatile("s_waitcnt lgkmcnt(" #n ")" ::: "memory")
#define PG8_BAR __builtin_amdgcn_s_barrier()
#define PG8_SCHED __builtin_amdgcn_sched_barrier(0)
    Unit cur, nxt; int ui = 0;
    LAS float* rsl = (LAS float*)(lds + LDS_RS_OFF);
    if (E.rs) { Unit uu; for (int i = 0; i < LDS_RS_UNITS && S.next(i, uu); ++i) if (tid < 256) rsl[i * 256 + tid] = E.rs[uu.pm * BM + tid]; }
    __syncthreads();
    if (!S.next(0, cur)) return;
    f32x4 acc[2][2][4][2];
#pragma unroll
    for (int a = 0; a < 2; ++a)
#pragma unroll
        for (int b = 0; b < 2; ++b)
#pragma unroll
            for (int m = 0; m < 4; ++m)
#pragma unroll
                for (int n = 0; n < 2; ++n) acc[a][b][m][n] = (f32x4){0.f, 0.f, 0.f, 0.f};
    bf16x8 At[4][2], B0[2][2], B1[2][2];
    const char* cA = (const char*)g.A + (size_t)cur.pm * tstep; const char* cB = (const char*)g.Bt + (size_t)cur.pn * tstep;
    PG8_STAGE(PG8_SB(0, 0), cB, voffB); PG8_STAGE(PG8_SA(0, 0), cA, voffA); PG8_STAGE(PG8_SB(0, 1), cB + hstep, voffB); PG8_STAGE(PG8_SA(0, 1), cA + hstep, voffA);
    if (wr == 1) PG8_BAR;
    PG8_WAIT_V(4); PG8_BAR;
    PG8_STAGE(PG8_SB(1, 0), cB + kstep, voffB); PG8_STAGE(PG8_SA(1, 0), cA + kstep, voffA); PG8_STAGE(PG8_SB(1, 1), cB + hstep + kstep, voffB);
    PG8_WAIT_V(6); PG8_BAR;
    for (;;) {
        const bool has_next = S.next(ui + 1, nxt);
        const char* nA = has_next ? (const char*)g.A + (size_t)nxt.pm * tstep : cA; const char* nB = has_next ? (const char*)g.Bt + (size_t)nxt.pn * tstep : cB;
        for (int t = 0; t < nt; t += 2) {
            const bool last = (t == nt - 2);
            const char* a1 = cA + (size_t)(t + 1) * kstep;
            const char* a2 = last ? nA : cA + (size_t)(t + 2) * kstep; const char* b2 = last ? nB : cB + (size_t)(t + 2) * kstep;
            const char* a3 = a2 + kstep; const char* b3 = b2 + kstep;
            PG8_LDB(B0, 0, 0); PG8_SCHED; PG8_LDA(At, 0, 0); PG8_STAGE(PG8_SA(1, 1), a1 + hstep, voffA);
            PG8_WAIT_L(8); PG8_BAR; PG8_WAIT_L(0); PG8_MMA(0, 0, At, B0); PG8_BAR; PG8_SCHED;
            PG8_LDB(B1, 0, 1); PG8_STAGE(PG8_SB(0, 0), b2, voffB);
            PG8_BAR; PG8_WAIT_L(0); PG8_MMA(0, 1, At, B1); PG8_BAR;
            PG8_LDA(At, 0, 1); PG8_STAGE(PG8_SA(0, 0), a2, voffA);
            PG8_BAR; PG8_WAIT_L(0); PG8_MMA(1, 0, At, B0); PG8_BAR; PG8_SCHED;
            PG8_STAGE(PG8_SB(0, 1), b2 + hstep, voffB);
            PG8_WAIT_V(6); PG8_BAR; PG8_MMA(1, 1, At, B1); PG8_BAR;
            PG8_LDB(B0, 1, 0); PG8_SCHED; PG8_LDA(At, 1, 0); PG8_STAGE(PG8_SA(0, 1), a2 + hstep, voffA);
            PG8_WAIT_L(8); PG8_BAR; PG8_WAIT_L(0); PG8_MMA(0, 0, At, B0); PG8_BAR; PG8_SCHED;
            PG8_LDB(B1, 1, 1); PG8_STAGE(PG8_SB(1, 0), b3, voffB);
            PG8_BAR; PG8_WAIT_L(0); PG8_MMA(0, 1, At, B1); PG8_BAR;
            PG8_LDA(At, 1, 1); PG8_STAGE(PG8_SA(1, 0), a3, voffA);
            PG8_BAR; PG8_WAIT_L(0); PG8_MMA(1, 0, At, B0); PG8_BAR; PG8_SCHED;
            PG8_STAGE(PG8_SB(1, 1), b3 + hstep, voffB);
            PG8_WAIT_V(6); PG8_BAR; PG8_MMA(1, 1, At, B1); PG8_BAR;
        }
        E(acc, cur, wr, wc, fr, fq, rsl + ui * 256);
        if (!has_next) break;
#pragma unroll
        for (int a = 0; a < 2; ++a)
#pragma unroll
            for (int b = 0; b < 2; ++b)
#pragma unroll
                for (int m = 0; m < 4; ++m)
#pragma unroll
                    for (int n = 0; n < 2; ++n) acc[a][b][m][n] = (f32x4){0.f, 0.f, 0.f, 0.f};
        cur = nxt; cA = nA; cB = nB; ++ui;
    }
    PG8_WAIT_V(0);
    if (wr == 0) PG8_BAR;
    PG8_BAR;
#undef PG8_SA
#undef PG8_SB
#undef PG8_STAGE
#undef PG8_LDA
#undef PG8_LDB
#undef PG8_MMA
#undef PG8_WAIT_V
#undef PG8_WAIT_L
#undef PG8_BAR
#undef PG8_SCHED
}
}

__device__ __forceinline__ void skinny16(LAS unsigned char* lds, const bf16_t* A, int K, const bf16_t* Bt, int ntiles, int mode, bf16_t* O, int ldo, const float* rs, const int tid, const int bid) {
    const int wid = __builtin_amdgcn_readfirstlane(tid >> 6), lane = tid & 63, fr = lane & 15, fq = lane >> 4;
    LAS f32x4* RED = (LAS f32x4*)lds;
    const int nsteps = K / 32;
    for (int tile = (int)gridDim.x - 1 - bid; tile < ntiles; tile += gridDim.x) {
        const int c0 = 16 * tile, rb0 = mode ? ((c0 >> 7) * 256 + (c0 & 127)) : c0;
        f32x4 acc0 = (f32x4){0.f, 0.f, 0.f, 0.f}, acc1 = (f32x4){0.f, 0.f, 0.f, 0.f};
        const bf16_t* ap = A + (size_t)fr * K + fq * 8;
        const bf16_t* bp0 = Bt + (size_t)(rb0 + fr) * K + fq * 8;
        const bf16_t* bp1 = bp0 + (size_t)128 * K;
        for (int s = wid; s < nsteps; s += 32) {
            bf16x8 a[4], b0[4], b1[4];
#pragma unroll
            for (int j = 0; j < 4; ++j) { const int sj = s + 8 * j, sc = sj < nsteps ? sj : s;
                a[j] = *(const bf16x8*)(ap + sc * 32); b0[j] = *(const bf16x8*)(bp0 + sc * 32); if (mode) b1[j] = *(const bf16x8*)(bp1 + sc * 32); }
#pragma unroll
            for (int j = 0; j < 4; ++j) if (s + 8 * j < nsteps) {
                acc0 = __builtin_amdgcn_mfma_f32_16x16x32_bf16(b0[j], a[j], acc0, 0, 0, 0);
                if (mode) acc1 = __builtin_amdgcn_mfma_f32_16x16x32_bf16(b1[j], a[j], acc1, 0, 0, 0); }
        }
        RED[(wid * 2 + 0) * 64 + lane] = acc0; RED[(wid * 2 + 1) * 64 + lane] = acc1;
        __syncthreads();
        if (wid == 0) {
            f32x4 s0 = (f32x4){0.f, 0.f, 0.f, 0.f}, s1 = s0;
#pragma unroll
            for (int w = 0; w < 8; ++w) { s0 += RED[(w * 2 + 0) * 64 + lane]; s1 += RED[(w * 2 + 1) * 64 + lane]; }
            if (rs) { const float sc = rs[fr]; s0 *= sc; s1 *= sc; }
            if (mode) {
#pragma unroll
                for (int j = 0; j < 4; ++j) s0[j] = silu_f(s0[j]) * s1[j];
            }
            u32x2 w; w.x = cvt_pk_bf16(s0[0], s0[1]); w.y = cvt_pk_bf16(s0[2], s0[3]);
            *(u32x2*)(O + (size_t)fr * ldo + c0 + 4 * fq) = w;
        }
        __syncthreads();
    }
}

struct TileDesc { const float* src; bf16_t* dst; const float* g; int N, K; };
__device__ __forceinline__ TileDesc decode_tile(const Params& p, int g) {
    const float* W; bf16_t* out; const float* gn = nullptr; int K, N, mode, loc;
    if (g < 688)       { W = p.in[3];  out = (bf16_t*)(p.ws + WS_W1A); K = D;   N = DFF;  mode = 1; loc = g; gn = p.in[2]; }
    else if (g < 1376) { W = p.in[4];  out = (bf16_t*)(p.ws + WS_W1A); K = D;   N = DFF;  mode = 2; loc = g - 688; gn = p.in[2]; }
    else if (g < 2064) { W = p.in[5];  out = (bf16_t*)(p.ws + WS_W1B); K = DFF; N = D;    mode = 0; loc = g - 1376; }
    else if (g < 2704) { W = p.in[8];  out = (bf16_t*)(p.ws + WS_WIN); K = D;   N = NINC; mode = 0; loc = g - 2064; gn = p.in[7]; }
    else if (g < 2960) { W = p.in[19]; out = (bf16_t*)(p.ws + WS_WOUT); K = D;  N = D;    mode = 0; loc = g - 2704; }
    else if (g < 3648) { W = p.in[22]; out = (bf16_t*)(p.ws + WS_W2A); K = D;   N = DFF;  mode = 1; loc = g - 2960; gn = p.in[21]; }
    else if (g < 4336) { W = p.in[23]; out = (bf16_t*)(p.ws + WS_W2A); K = D;   N = DFF;  mode = 2; loc = g - 3648; gn = p.in[21]; }
    else               { W = p.in[24]; out = (bf16_t*)(p.ws + WS_W2B); K = DFF; N = D;    mode = 0; loc = g - 4336; }
    const int nNt = N / 128, kt = loc / nNt, ntl = loc % nNt;
    const int rowbase = mode == 0 ? ntl * 128 : ntl * 256 + (mode == 2 ? 128 : 0);
    TileDesc t; t.src = W + (size_t)(kt * 128) * N + ntl * 128; t.dst = out + (size_t)rowbase * K + kt * 128; t.g = gn ? gn + kt * 128 : nullptr; t.N = N; t.K = K; return t;
}
constexpr int PREP_TILES = 5024;
__device__ __forceinline__ void prep_weights(const Params& p, LAS unsigned char* lds, const int tid, const int bid) {
    LAS float* T = (LAS float*)lds;
    const int r = tid >> 5, c4 = tid & 31;
    int g = bid;
    if (g >= PREP_TILES) return;
    TileDesc td = decode_tile(p, g);
    f32x4 v[8];
#pragma unroll
    for (int i = 0; i < 8; ++i) v[i] = *(const f32x4*)(td.src + (size_t)(r + 16 * i) * td.N + 4 * c4);
    for (;;) {
#pragma unroll
        for (int i = 0; i < 8; ++i) { const int k = r + 16 * i; *(LAS f32x4*)(T + k * 132 + 4 * (c4 ^ ((k >> 3) & 7))) = v[i]; }
        __syncthreads();
        const int gn = g + gridDim.x; const bool has_next = gn < PREP_TILES;
        TileDesc tn = td;
        if (has_next) { tn = decode_tile(p, gn);
#pragma unroll
            for (int i = 0; i < 8; ++i) v[i] = *(const f32x4*)(tn.src + (size_t)(r + 16 * i) * tn.N + 4 * c4); }
#pragma unroll
        for (int p2 = 0; p2 < 4; ++p2) { const int cch = tid & 15, nn = (tid >> 4) + 32 * p2, k8 = 8 * cch, ncol = nn ^ (4 * (cch & 7)); float x[8];
#pragma unroll
            for (int i = 0; i < 8; ++i) x[i] = T[(k8 + i) * 132 + ncol];
            if (td.g) { const f32x4 g0 = *(const f32x4*)(td.g + k8), g1 = *(const f32x4*)(td.g + k8 + 4);
                x[0] *= g0[0]; x[1] *= g0[1]; x[2] *= g0[2]; x[3] *= g0[3]; x[4] *= g1[0]; x[5] *= g1[1]; x[6] *= g1[2]; x[7] *= g1[3]; }
            u32x4 w; w.x = cvt_pk_bf16(x[0], x[1]); w.y = cvt_pk_bf16(x[2], x[3]); w.z = cvt_pk_bf16(x[4], x[5]); w.w = cvt_pk_bf16(x[6], x[7]);
            *(u32x4*)(td.dst + (size_t)nn * td.K + k8) = w; }
        __syncthreads();
        if (!has_next) break;
        g = gn; td = tn;
    }
}

__device__ __forceinline__ void ew_phase(const bf16_t* F, float coef, const float* gpost, const float* hx, const float* meta, const bf16_t* hb, float* out32, bf16_t* hbo, float* rso, int nrows, const int tid, const int bid) {
    const int lane = tid & 63, gw = bid * 8 + (tid >> 6), nw = gridDim.x * 8;
    for (int r0 = gw; r0 < nrows; r0 += 2 * nw) {
        int rr[2]; rr[0] = r0; rr[1] = (r0 + nw < nrows) ? r0 + nw : r0;
        f32x4 h[2][8]; u32x2 fw[2][8];
#pragma unroll
        for (int q = 0; q < 2; ++q) { const int r = rr[q];
            if (hx) { const float* hp = r < MX ? hx + (size_t)r * D : meta + (size_t)(r - MX) * D;
#pragma unroll
                for (int i = 0; i < 8; ++i) h[q][i] = *(const f32x4*)(hp + i * 256 + lane * 4); }
            else {
#pragma unroll
                for (int i = 0; i < 8; ++i) { const u32x2 w = *(const u32x2*)(hb + (size_t)r * D + i * 256 + lane * 4); h[q][i] = (f32x4){bflo(w.x), bfhi(w.x), bflo(w.y), bfhi(w.y)}; } }
            if (F) {
#pragma unroll
                for (int i = 0; i < 8; ++i) fw[q][i] = *(const u32x2*)(F + (size_t)r * D + i * 256 + lane * 4); } }
#pragma unroll
        for (int q = 0; q < 2; ++q) { const int r = rr[q];
            if (F) {
                f32x4 f[8]; float ss = 0.f;
#pragma unroll
                for (int i = 0; i < 8; ++i) { const u32x2 w = fw[q][i]; f[i] = (f32x4){bflo(w.x), bfhi(w.x), bflo(w.y), bfhi(w.y)}; ss += (f[i][0] * f[i][0] + f[i][1] * f[i][1]) + (f[i][2] * f[i][2] + f[i][3] * f[i][3]); }
                ss = wave64_sum(ss);
                const float rs = coef * rsqrtf(ss * (1.0f / D) + EPS);
#pragma unroll
                for (int i = 0; i < 8; ++i) { const f32x4 g = *(const f32x4*)(gpost + i * 256 + lane * 4); h[q][i] += f[i] * rs * g; }
            }
            if (out32 && r < MX) {
#pragma unroll
                for (int i = 0; i < 8; ++i) *(f32x4*)(out32 + (size_t)r * D + i * 256 + lane * 4) = h[q][i];
            }
            if (hbo) {
                float ss = 0.f;
#pragma unroll
                for (int i = 0; i < 8; ++i) ss += (h[q][i][0] * h[q][i][0] + h[q][i][1] * h[q][i][1]) + (h[q][i][2] * h[q][i][2] + h[q][i][3] * h[q][i][3]);
                ss = wave64_sum(ss);
                if (lane == 0) rso[r] = rsqrtf(ss * (1.0f / D) + EPS);
#pragma unroll
                for (int i = 0; i < 8; ++i) { u32x2 w; w.x = cvt_pk_bf16(h[q][i][0], h[q][i][1]); w.y = cvt_pk_bf16(h[q][i][2], h[q][i][3]);
                    *(u32x2*)(hbo + (size_t)r * D + i * 256 + lane * 4) = w; }
            }
        }
    }
}

constexpr int L_XIN = 0, L_XC = 17152, L_AA = L_XC + 16640, L_UU = L_AA + 16640, L_XCB = L_UU + 16640, L_WA = L_XCB + 9216, L_WX = L_WA + 9216, L_PART = L_WX + 9216, L_END = L_PART + 4096;
static_assert(L_END <= LDS_MAIN, "mixer LDS");
constexpr int NRUN = 16;
struct HeadConst { float cw0, cw1, cw2, cw3, cb, go; float sp[8], ba[8], bx[8]; };
__device__ __forceinline__ void lru_load_head(const Params& p, LAS unsigned char* lds, int h, const int tid, HeadConst& hc) {
    LAS bf16_t* WA = (LAS bf16_t*)(lds + L_WA); LAS bf16_t* WX = (LAS bf16_t*)(lds + L_WX);
    const float* wa = p.in[11] + (size_t)h * 4096; const float* wx = p.in[13] + (size_t)h * 4096;
    for (int e = tid; e < 4096; e += 512) { const int i = e >> 6, j = e & 63; WA[j * 72 + i] = f2bf(wa[e]); WX[j * 72 + i] = f2bf(wx[e]); }
    const int lane = tid & 63, wid = tid >> 6, fq = lane >> 4, nh = wid >> 2, ch = 64 * h + lane;
    hc.cw0 = p.in[9][ch]; hc.cw1 = p.in[9][DL + ch]; hc.cw2 = p.in[9][2 * DL + ch]; hc.cw3 = p.in[9][3 * DL + ch]; hc.cb = p.in[10][ch]; hc.go = p.in[17][ch];
#pragma unroll
    for (int k = 0; k < 8; ++k) { const int c2 = 64 * h + 16 * (2 * nh + (k >> 2)) + 4 * fq + (k & 3);
        hc.sp[k] = -8.0f * log1pf(__expf(-p.in[15][c2])); hc.ba[k] = p.in[12][c2]; hc.bx[k] = p.in[14][c2]; }
}
struct XinRegs { u32x4 a, b; };
__device__ __forceinline__ void xin_prefetch(const bf16_t* Z, int b, int h, int v, const int tid, XinRegs& x) {
    const int s0 = v < 0 ? 0 : NMETA + 64 * v, ntok = v < 0 ? NMETA : 64;
    x.a = (u32x4){0u, 0u, 0u, 0u}; x.b = x.a;
    { const int row = tid >> 3, seg = tid & 7, s = s0 - 3 + row; if (s >= 0 && row < ntok + 3) x.a = *(const u32x4*)(Z + (size_t)zrow(b, s) * NINC + DL + 64 * h + 8 * seg); }
    if (tid < 24) { const int e = 512 + tid, row = e >> 3, seg = e & 7, s = s0 - 3 + row; if (s >= 0 && row < ntok + 3) x.b = *(const u32x4*)(Z + (size_t)zrow(b, s) * NINC + DL + 64 * h + 8 * seg); }
}
__device__ __forceinline__ void xin_store(LAS float* XIN, const int tid, const XinRegs& x) {
    { LAS float* d = XIN + tid * 8; *(LAS f32x4*)d = (f32x4){bflo(x.a.x), bfhi(x.a.x), bflo(x.a.y), bfhi(x.a.y)}; *(LAS f32x4*)(d + 4) = (f32x4){bflo(x.a.z), bfhi(x.a.z), bflo(x.a.w), bfhi(x.a.w)}; }
    if (tid < 24) { LAS float* d = XIN + (512 + tid) * 8; *(LAS f32x4*)d = (f32x4){bflo(x.b.x), bfhi(x.b.x), bflo(x.b.y), bfhi(x.b.y)}; *(LAS f32x4*)(d + 4) = (f32x4){bflo(x.b.z), bfhi(x.b.z), bflo(x.b.w), bfhi(x.b.w)}; }
}
__device__ __forceinline__ void lru_tile_math(LAS unsigned char* lds, const int tid, const HeadConst& hc) {
    const int wid = __builtin_amdgcn_readfirstlane(tid >> 6), lane = tid & 63, fr = lane & 15, fq = lane >> 4;
    LAS float* XIN = (LAS float*)(lds + L_XIN); LAS float* XC = (LAS float*)(lds + L_XC); LAS float* AA = (LAS float*)(lds + L_AA); LAS float* UU = (LAS float*)(lds + L_UU);
    LAS bf16_t* XCB = (LAS bf16_t*)(lds + L_XCB); LAS bf16_t* WA = (LAS bf16_t*)(lds + L_WA); LAS bf16_t* WX = (LAS bf16_t*)(lds + L_WX);
    { const int c = lane;
#pragma unroll
      for (int q = 0; q < 8; ++q) { const int t = wid + 8 * q;
          const float xc = hc.cb + hc.cw0 * XIN[t * 64 + c] + hc.cw1 * XIN[(t + 1) * 64 + c] + hc.cw2 * XIN[(t + 2) * 64 + c] + hc.cw3 * XIN[(t + 3) * 64 + c];
          XC[t * 65 + c] = xc; XCB[t * 72 + c] = f2bf(xc); } }
    __syncthreads();
    { const int mt = wid & 3, nh = wid >> 2, tok = 16 * mt + fr;
#pragma unroll
      for (int nbi = 0; nbi < 2; ++nbi) { const int nb = 2 * nh + nbi;
          f32x4 ga = (f32x4){0.f, 0.f, 0.f, 0.f}, gx = ga;
#pragma unroll
          for (int ks = 0; ks < 2; ++ks) {
              const bf16x8 xf = *(const LAS bf16x8*)(XCB + tok * 72 + 32 * ks + 8 * fq);
              const bf16x8 waf = *(const LAS bf16x8*)(WA + (16 * nb + fr) * 72 + 32 * ks + 8 * fq);
              const bf16x8 wxf = *(const LAS bf16x8*)(WX + (16 * nb + fr) * 72 + 32 * ks + 8 * fq);
              ga = __builtin_amdgcn_mfma_f32_16x16x32_bf16(waf, xf, ga, 0, 0, 0);
              gx = __builtin_amdgcn_mfma_f32_16x16x32_bf16(wxf, xf, gx, 0, 0, 0); }
#pragma unroll
          for (int r = 0; r < 4; ++r) { const int col = 16 * nb + 4 * fq + r, k = nbi * 4 + r;
              const float a_g = __builtin_amdgcn_rcpf(1.0f + __expf(-(ga[r] + hc.ba[k]))), x_g = __builtin_amdgcn_rcpf(1.0f + __expf(-(gx[r] + hc.bx[k])));
              const float la = a_g * hc.sp[k];
              const float a = __expf(la), x2 = 2.0f * la;
              const float ser = -x2 * (1.0f + x2 * (0.5f + x2 * (0.16666667f + x2 * (0.041666668f + x2 * (0.0083333338f + x2 * 0.0013888889f)))));
              const float om = x2 > -0.25f ? ser : 1.0f - a * a;
              AA[tok * 65 + col] = a; UU[tok * 65 + col] = __builtin_amdgcn_sqrtf(om) * x_g * XC[tok * 65 + col]; } } }
    __syncthreads();
}
__device__ __forceinline__ void mixer_lru_scan(const Params& p, LAS unsigned char* lds, const int tid, const int bid) {
    const int wid = __builtin_amdgcn_readfirstlane(tid >> 6), lane = tid & 63;
    LAS float* XIN = (LAS float*)(lds + L_XIN); LAS float* AA = (LAS float*)(lds + L_AA); LAS float* UU = (LAS float*)(lds + L_UU); LAS float* PART = (LAS float*)(lds + L_PART);
    float* RSA = (float*)(p.ws + WS_SUMA); float* RSH = (float*)(p.ws + WS_SUMH);
    const bf16_t* Z = (const bf16_t*)(p.ws + WS_Z); unsigned* HP = (unsigned*)(p.ws + WS_F);
    int hl = -1; HeadConst hc;
    for (int it = bid; it < NBATCH * 16 * NRUN; it += gridDim.x) {
        const int h = it & 15, b = it >> 8, run = ((it >> 4) + b) & 15, ch = 64 * h + lane;
        if (h != hl) { lru_load_head(p, lds, h, tid, hc); hl = h; }
        const int v0 = run == 0 ? -1 : 4 * run, v1 = 4 * run + 4;
        float cinH = 0.f, cinA = 1.f;
        XinRegs xr; xin_prefetch(Z, b, h, v0, tid, xr);
        for (int v = v0; v < v1; ++v) {
            const int ntok = v < 0 ? NMETA : 64;
            xin_store(XIN, tid, xr);
            __syncthreads();
            if (v + 1 < v1) xin_prefetch(Z, b, h, v + 1, tid, xr);
            lru_tile_math(lds, tid, hc);
            float a[8], u[8]; float A = 1.f, H = 0.f;
#pragma unroll
            for (int i = 0; i < 8; ++i) { const int t = 8 * wid + i; a[i] = AA[t * 65 + lane]; u[i] = UU[t * 65 + lane]; if (t < ntok) { H = a[i] * H + u[i]; A *= a[i]; } }
            PART[(wid * 2 + 0) * 64 + lane] = A; PART[(wid * 2 + 1) * 64 + lane] = H;
            __syncthreads();
            float hcur = cinH, pcur = cinA;
#pragma unroll
            for (int w = 0; w < 8; ++w) { const float pa = PART[(w * 2 + 0) * 64 + lane], ph = PART[(w * 2 + 1) * 64 + lane]; cinH = pa * cinH + ph; cinA *= pa; if (w < wid) { hcur = pa * hcur + ph; pcur *= pa; } }
            if (v >= 0) {
                unsigned* hp = HP + ((size_t)b * SEQ + 64 * v + 8 * wid) * DL + ch;
#pragma unroll
                for (int i = 0; i < 8; ++i) { hcur = a[i] * hcur + u[i]; pcur *= a[i]; hp[(size_t)i * DL] = cvt_pk_bf16(hcur, pcur); }
            }
        }
        if (wid == 0) { RSA[(size_t)(b * NRUN + run) * DL + ch] = cinA; RSH[(size_t)(b * NRUN + run) * DL + ch] = cinH; }
    }
}
__device__ __forceinline__ void mixer_lru_out(const Params& p, const int tid, const int bid) {
    const int wid = tid >> 6, lane = tid & 63;
    const float* RSA = (const float*)(p.ws + WS_SUMA); const float* RSH = (const float*)(p.ws + WS_SUMH);
    const bf16_t* Z = (const bf16_t*)(p.ws + WS_Z); const unsigned* HP = (const unsigned*)(p.ws + WS_F); bf16_t* MIX = (bf16_t*)p.out;
    for (int wi = bid * 8 + wid; wi < NBATCH * NRUN * 8 * 4; wi += gridDim.x * 8) {
        const int q = wi & 3, chunk = (wi >> 2) & 7, run = (wi >> 5) & 15, b = wi >> 9, col = 256 * q + 4 * lane;
        f32x4 cin = (f32x4){0.f, 0.f, 0.f, 0.f};
        { f32x4 sa[NRUN - 1], sh[NRUN - 1];
#pragma unroll
          for (int rr = 0; rr < NRUN - 1; ++rr) { const size_t o = (size_t)(b * NRUN + (rr < run ? rr : 0)) * DL + col; sa[rr] = *(const f32x4*)(RSA + o); sh[rr] = *(const f32x4*)(RSH + o); }
#pragma unroll
          for (int rr = 0; rr < NRUN - 1; ++rr) if (rr < run) cin = sa[rr] * cin + sh[rr]; }
        const f32x4 go = *(const f32x4*)(p.in[17] + col);
        const size_t row0 = (size_t)b * SEQ + 256 * run + 32 * chunk;
#pragma unroll 8
        for (int i = 0; i < 32; ++i) { const size_t row = row0 + i;
            const u32x4 hp = *(const u32x4*)(HP + row * DL + col);
            const u32x2 yw = *(const u32x2*)(Z + row * NINC + col);
            const f32x4 hh = (f32x4){bflo(hp.x) + bfhi(hp.x) * cin[0], bflo(hp.y) + bfhi(hp.y) * cin[1], bflo(hp.z) + bfhi(hp.z) * cin[2], bflo(hp.w) + bfhi(hp.w) * cin[3]};
            const f32x4 y = (f32x4){bflo(yw.x), bfhi(yw.x), bflo(yw.y), bfhi(yw.y)};
            f32x4 vv;
#pragma unroll
            for (int k = 0; k < 4; ++k) { const float z2 = y[k] * (1.5957691216057308f + 0.07135481627f * y[k] * y[k]);
                vv[k] = hh[k] * y[k] * __builtin_amdgcn_rcpf(1.0f + __expf(-z2)); }
            const float ss = row16_sum((vv[0] * vv[0] + vv[1] * vv[1]) + (vv[2] * vv[2] + vv[3] * vv[3]));
            const f32x4 r = vv * __builtin_amdgcn_rsqf(ss * (1.0f / 64.0f) + EPS) * go;
            u32x2 w; w.x = cvt_pk_bf16(r[0], r[1]); w.y = cvt_pk_bf16(r[2], r[3]);
            *(u32x2*)(MIX + row * D + col) = w; }
    }
}
__device__ __forceinline__ void mixer_sconv(const Params& p, const int tid, const int bid) {
    const int wid = tid >> 6, lane = tid & 63;
    const bf16_t* Z = (const bf16_t*)(p.ws + WS_Z); bf16_t* MIX = (bf16_t*)p.out;
    for (int wi = bid * 8 + wid; wi < NBATCH * 128 * 4; wi += gridDim.x * 8) {
        const int q = wi & 3, c32 = (wi >> 2) & 127, b = wi >> 9, col = 256 * q + 4 * lane;
        const f32x4 w0 = *(const f32x4*)(p.in[16] + col), w1 = *(const f32x4*)(p.in[16] + DL + col), w2 = *(const f32x4*)(p.in[16] + 2 * DL + col), gg = *(const f32x4*)(p.in[18] + col);
        const int t0 = 32 * c32, s = NMETA + t0;
        f32x4 cvm2, cvm1;
        { const size_t r2 = (size_t)zrow(b, s - 2) * NINC + col, r1 = (size_t)zrow(b, s - 1) * NINC + col;
          const u32x2 c2 = *(const u32x2*)(Z + r2 + 3 * DL), v2 = *(const u32x2*)(Z + r2 + 4 * DL), c1 = *(const u32x2*)(Z + r1 + 3 * DL), v1 = *(const u32x2*)(Z + r1 + 4 * DL);
          cvm2 = (f32x4){bflo(c2.x) * bflo(v2.x), bfhi(c2.x) * bfhi(v2.x), bflo(c2.y) * bflo(v2.y), bfhi(c2.y) * bfhi(v2.y)};
          cvm1 = (f32x4){bflo(c1.x) * bflo(v1.x), bfhi(c1.x) * bfhi(v1.x), bflo(c1.y) * bflo(v1.y), bfhi(c1.y) * bfhi(v1.y)}; }
#pragma unroll 8
        for (int i = 0; i < 32; ++i) { const size_t row = (size_t)b * SEQ + t0 + i; const size_t zr = row * NINC + col;
            const u32x2 cw = *(const u32x2*)(Z + zr + 3 * DL), vw = *(const u32x2*)(Z + zr + 4 * DL), bw = *(const u32x2*)(Z + zr + 2 * DL);
            const f32x4 cv0 = (f32x4){bflo(cw.x) * bflo(vw.x), bfhi(cw.x) * bfhi(vw.x), bflo(cw.y) * bflo(vw.y), bfhi(cw.y) * bfhi(vw.y)};
            const f32x4 bs = (f32x4){bflo(bw.x), bfhi(bw.x), bflo(bw.y), bfhi(bw.y)};
            const f32x4 o = bs * (w0 * cvm2 + w1 * cvm1 + w2 * cv0);
            const float ss = row16_sum((o[0] * o[0] + o[1] * o[1]) + (o[2] * o[2] + o[3] * o[3]));
            const f32x4 r = o * (rsqrtf(ss * (1.0f / 64.0f) + EPS)) * gg;
            u32x2 w; w.x = cvt_pk_bf16(r[0], r[1]); w.y = cvt_pk_bf16(r[2], r[3]);
            *(u32x2*)(MIX + row * D + DL + col) = w;
            cvm2 = cvm1; cvm1 = cv0; }
    }
}

#define XB_TMO      128
#define XB_XCNT(j)  (256  + 64 * (j))
#define XB_XSUB(j)  (1280 + 64 * (j))
#define XB_XGEN(j)  (2304 + 64 * (j))
#define XB_TOP      3328
#define XB_TOPGEN   3392
#define XCD_BAR_WORDS 3456
#define XB_SPIN_CAP (1u << 20)
__device__ __forceinline__ unsigned xb_ld(unsigned* p)              { return __hip_atomic_load(p, __ATOMIC_RELAXED, __HIP_MEMORY_SCOPE_AGENT); }
__device__ __forceinline__ unsigned xb_add(unsigned* p, unsigned v) { return __hip_atomic_fetch_add(p, v, __ATOMIC_RELAXED, __HIP_MEMORY_SCOPE_AGENT); }
__device__ __forceinline__ unsigned xb_xcc_id() { return (unsigned)__builtin_amdgcn_s_getreg((3 << 11) | 20) & 0xFu; }
#define XB_SPIN(cond, bar) do { unsigned _sp = 0; while (cond) { __builtin_amdgcn_s_sleep(1); \
    if ((++_sp & 255u) == 0u) { if (xb_ld(&(bar)[XB_TMO])) break; if (_sp > XB_SPIN_CAP) { atomicAdd(&(bar)[XB_TMO], 1u); break; } } } } while (0)
struct XcdBarrier { unsigned* bar; unsigned x; volatile LAS unsigned* st; };
__device__ __forceinline__ XcdBarrier xcd_barrier_post(unsigned* bar, volatile LAS unsigned* st) {
    XcdBarrier b; b.bar = bar; b.x = xb_xcc_id(); b.st = st;
    if (threadIdx.x == 0) (void)xb_add(&bar[XB_XCNT(b.x)], 1u);
    return b;
}
__device__ __forceinline__ void xcd_barrier_complete(unsigned* bar, unsigned x, unsigned& nloc, unsigned& nx) {
    const unsigned G = gridDim.x * gridDim.y * gridDim.z;
    unsigned sum, cnt, mine, sp = 0u;
    for (;;) {
        sum = 0u; cnt = 0u; mine = 0u;
#pragma unroll
        for (unsigned j = 0; j < 16; ++j) { const unsigned c = xb_ld(&bar[XB_XCNT(j)]); sum += c; cnt += (c > 0u) ? 1u : 0u; mine = (j == x) ? c : mine; }
        if (sum == G) break;
        __builtin_amdgcn_s_sleep(1);
        if ((++sp & 255u) == 0u) { if (xb_ld(&bar[XB_TMO])) break; if (sp > XB_SPIN_CAP) { atomicAdd(&bar[XB_TMO], 1u); break; } }
    }
    nloc = mine > 0u ? mine : 1u; nx = cnt > 0u ? cnt : 1u;
}
__device__ __forceinline__ void xcd_barrier(const XcdBarrier& b) {
    asm volatile("s_waitcnt vmcnt(0)" ::: "memory");
    __syncthreads();
    if (threadIdx.x == 0) {
        unsigned* bar = b.bar;
        __builtin_amdgcn_s_waitcnt(0);
        unsigned nloc = b.st[0], nx = b.st[1];
        if (nloc == 0u) { xcd_barrier_complete(bar, b.x, nloc, nx); b.st[0] = nloc; b.st[1] = nx; }
        const unsigned old = xb_add(&bar[XB_XSUB(b.x)], 1u);
        const unsigned gen = old / nloc;
        if (old + 1u == (gen + 1u) * nloc) {
            __builtin_amdgcn_fence(__ATOMIC_RELEASE, "agent");
            asm volatile("s_waitcnt vmcnt(0)" ::: "memory");
            const unsigned og = xb_add(&bar[XB_TOP], 1u);
            const unsigned tg = og / nx;
            if (og + 1u == (tg + 1u) * nx) xb_add(&bar[XB_TOPGEN], 1u);
            else XB_SPIN(xb_ld(&bar[XB_TOPGEN]) == tg, bar);
            __builtin_amdgcn_fence(__ATOMIC_ACQUIRE, "agent");
            xb_add(&bar[XB_XGEN(b.x)], 1u);
            asm volatile("s_waitcnt vmcnt(0)" ::: "memory");
        } else {
            XB_SPIN(xb_ld(&bar[XB_XGEN(b.x)]) == gen, bar);
            __builtin_amdgcn_fence(__ATOMIC_ACQUIRE, "agent");
            asm volatile("s_waitcnt vmcnt(0)" ::: "memory");
        }
    }
    __syncthreads();
}

__global__ void __launch_bounds__(512, 2) fwd_kernel(Params p) {
    extern __shared__ __attribute__((aligned(16))) unsigned char lds_raw[];
    LAS unsigned char* lds = (LAS unsigned char*)lds_raw;
    cg::grid_group grid = cg::this_grid();
    volatile LAS unsigned* xst = (volatile LAS unsigned*)(lds + LDS_MAIN);
    if (threadIdx.x == 0) { xst[0] = 0u; xst[1] = 0u; }
    __syncthreads();
    const XcdBarrier xbar = xcd_barrier_post((unsigned*)(p.ws + WS_BAR), xst);
    if (p.ph_hi > NPHASE + 100) grid.sync();
    bf16_t* W1A = (bf16_t*)(p.ws + WS_W1A); bf16_t* W1B = (bf16_t*)(p.ws + WS_W1B); bf16_t* WIN = (bf16_t*)(p.ws + WS_WIN); bf16_t* WOUT = (bf16_t*)(p.ws + WS_WOUT);
    bf16_t* W2A = (bf16_t*)(p.ws + WS_W2A); bf16_t* W2B = (bf16_t*)(p.ws + WS_W2B);
    bf16_t* HB = (bf16_t*)(p.ws + WS_ABUF); bf16_t* MIXB = (bf16_t*)p.out; float* RS = (float*)(p.ws + WS_RS); bf16_t* ACT = (bf16_t*)(p.ws + WS_ACT); bf16_t* FB = (bf16_t*)(p.ws + WS_F); bf16_t* ZB = (bf16_t*)(p.ws + WS_Z);
    for (int ph = p.ph_lo; ph < p.ph_hi; ++ph) {
      const int nrep = ((REPMASK >> ph) & 1) ? 2 : 1;
      for (int rep = 0; rep < nrep; ++rep) {
        int tid = threadIdx.x, bid = blockIdx.x;
        asm volatile("" : "+v"(tid), "+s"(bid));
        if (ph == 0 && (PHMASK & 1)) {
            prep_weights(p, lds, tid, bid);
            ew_phase(nullptr, 0.f, nullptr, p.in[0], p.in[1], nullptr, nullptr, HB, RS, MROWS, tid, bid);
        } else if ((ph == 1 || ph == 9) && (PHMASK & 2)) {
            pg8::Gemm g{HB, ph == 1 ? W1A : W2A, MX, 2 * DFF, D}; pg8::StaticOrder S; S.init(MX, 2 * DFF, gridDim.x, bid);
            pg8::EpiSwiglu E{ACT, DFF, RS};
            pg8::gemm_phase<pg8::EpiSwiglu>(lds, g, S, E, tid);
            if (ph == 1) skinny16(lds, HB + (size_t)MX * D, D, W1A, DFF / 16, 1, ACT + (size_t)MX * DFF, DFF, RS + MX, tid, bid);
        } else if ((ph == 2 || ph == 4 || ph == 7 || ph == 10) && (PHMASK & 4)) {
            const bf16_t* A; const bf16_t* Bt; bf16_t* O; int N, K; const float* rs = nullptr;
            if (ph == 2)      { A = ACT;  Bt = W1B;  O = FB; N = D;    K = DFF; }
            else if (ph == 4) { A = HB;   Bt = WIN;  O = ZB; N = NINC; K = D; rs = RS; }
            else if (ph == 7) { A = MIXB; Bt = WOUT; O = FB; N = D;    K = D; }
            else              { A = ACT;  Bt = W2B;  O = FB; N = D;    K = DFF; }
            pg8::Gemm g{A, Bt, MX, N, K}; pg8::StaticOrder S; S.init(MX, N, gridDim.x, bid);
            pg8::EpiBf16 E{O, N, rs};
            pg8::gemm_phase<pg8::EpiBf16>(lds, g, S, E, tid);
            if (ph == 2 || ph == 4) skinny16(lds, A + (size_t)MX * K, K, Bt, N / 16, 0, O + (size_t)MX * N, N, rs ? rs + MX : nullptr, tid, bid);
        } else if (ph == 3 && (PHMASK & 8)) {
            ew_phase(FB, 0.5f, p.in[6], nullptr, nullptr, HB, nullptr, HB, RS, MROWS, tid, bid);
        } else if (ph == 5 && (PHMASK & 16)) {
            mixer_lru_scan(p, lds, tid, bid); mixer_sconv(p, tid, bid);
        } else if (ph == 6 && (PHMASK & 32)) {
            mixer_lru_out(p, tid, bid);
        } else if (ph == 8 && (PHMASK & 8)) {
            ew_phase(FB, 1.0f, p.in[20], nullptr, nullptr, HB, nullptr, HB, RS, MX, tid, bid);
        } else if (ph == 11 && (PHMASK & 8)) {
            ew_phase(FB, 0.5f, p.in[25], nullptr, nullptr, HB, p.out, nullptr, nullptr, MX, tid, bid);
        }
        if (ph + 1 < p.ph_hi || rep + 1 < nrep) xcd_barrier(xbar);
      }
    }
}

extern "C" void kernel_launch(void* const* d_in, const int* in_sizes, int n_in, void* d_out, int out_size, void* d_ws, size_t ws_size, hipStream_t stream) {
    static int grid = 0;
    if (grid == 0) {
        if (n_in != 26 || out_size != MX * D || ws_size < WS_END) { fprintf(stderr, "kernel_launch: unexpected shapes (n_in %d out %d ws %zu need %zu)\n", n_in, out_size, ws_size, (size_t)WS_END); grid = -1; return; }
        int dev = 0, cus = 0, per_cu = 0;
        hipGetDevice(&dev); hipDeviceGetAttribute(&cus, hipDeviceAttributeMultiprocessorCount, dev);
        if (hipFuncSetAttribute((const void*)fwd_kernel, hipFuncAttributeMaxDynamicSharedMemorySize, LDS_BYTES) != hipSuccess) { fprintf(stderr, "kernel_launch: hipFuncSetAttribute failed\n"); grid = -1; return; }
        if (hipOccupancyMaxActiveBlocksPerMultiprocessor(&per_cu, (const void*)fwd_kernel, 512, LDS_BYTES) != hipSuccess || per_cu < 1) { fprintf(stderr, "kernel_launch: occupancy query gave %d\n", per_cu); per_cu = 1; }
        (void)hipGetLastError();
        grid = cus * 1;
        fprintf(stderr, "kernel_launch: grid %d (cus %d, per_cu %d)\n", grid, cus, per_cu);
    }
    if (grid < 0) return;
    if (hipMemsetAsync((char*)d_ws + WS_BAR, 0, XCD_BAR_WORDS * 4, stream) != hipSuccess) { fprintf(stderr, "kernel_launch: memset of the barrier words failed\n"); return; }
    Params p{};
    for (int i = 0; i < 26; ++i) p.in[i] = (const float*)d_in[i];
    p.out = (float*)d_out; p.ws = (unsigned char*)d_ws;
#if ONE_LAUNCH
    p.ph_lo = 0; p.ph_hi = NPHASE;
    { void* args[] = {&p}; hipError_t e = hipLaunchCooperativeKernel((const void*)fwd_kernel, dim3(grid), dim3(512), args, LDS_BYTES, stream);
      if (e != hipSuccess) fprintf(stderr, "cooperative launch failed: %s\n", hipGetErrorString(e)); }
#else
    for (int ph = 0; ph < NPHASE; ++ph) {
        p.ph_lo = ph; p.ph_hi = ph + 1;
        void* args[] = {&p}; hipError_t e = hipLaunchCooperativeKernel((const void*)fwd_kernel, dim3(grid), dim3(512), args, LDS_BYTES, stream);
        if (e != hipSuccess) { fprintf(stderr, "cooperative launch %d failed: %s\n", ph, hipGetErrorString(e)); break; }
    }
#endif
}
```

```cpp
#include <hip/hip_runtime.h>
#include <hip/hip_cooperative_groups.h>
#include <cstdio>
namespace cg = cooperative_groups;

#ifndef PHMASK
#define PHMASK 0xFFF
#endif
#ifndef REPMASK
#define REPMASK 0
#endif
#ifndef ONE_LAUNCH
#define ONE_LAUNCH 1
#endif

#define LAS __attribute__((address_space(3)))
typedef unsigned short bf16_t;
typedef short bf16x8 __attribute__((ext_vector_type(8)));
typedef float f32x4 __attribute__((ext_vector_type(4)));
typedef unsigned u32x4 __attribute__((ext_vector_type(4)));
typedef unsigned u32x2 __attribute__((ext_vector_type(2)));

constexpr int D = 2048, DFF = 5504, DL = 1024, NINC = 5120, SEQ = 4096, NBATCH = 4, NMETA = 16;
constexpr int MX = NBATCH * SEQ;
constexpr int MROWS = MX + NMETA;
constexpr int NTILE = 65;
constexpr float EPS = 1e-6f;
constexpr int NPHASE = 12;
constexpr int LDS_MAIN = 131072, LDS_RS_OFF = LDS_MAIN + 64, LDS_RS_UNITS = 24, LDS_BYTES = LDS_RS_OFF + LDS_RS_UNITS * 1024;

constexpr size_t SZ_WA = (size_t)2 * DFF * D * 2, SZ_WB = (size_t)D * DFF * 2, SZ_WIN = (size_t)NINC * D * 2, SZ_WOUT = (size_t)D * D * 2;
constexpr size_t WS_W1A = 0, WS_W1B = WS_W1A + SZ_WA, WS_WIN = WS_W1B + SZ_WB, WS_WOUT = WS_WIN + SZ_WIN, WS_W2A = WS_WOUT + SZ_WOUT, WS_W2B = WS_W2A + SZ_WA;
constexpr size_t WS_ABUF = WS_W2B + SZ_WB;
constexpr size_t WS_ACT = WS_ABUF + (size_t)MROWS * D * 2;
constexpr size_t WS_F = WS_ACT + (size_t)MROWS * DFF * 2;
constexpr size_t WS_Z = WS_ACT;
constexpr size_t WS_SUMA = WS_F + (size_t)MROWS * D * 2;
constexpr size_t WS_SUMH = WS_SUMA + (size_t)NBATCH * NTILE * DL * 4;
constexpr size_t WS_BAR = WS_SUMH + (size_t)NBATCH * NTILE * DL * 4;
constexpr size_t WS_RS = WS_BAR + 16384;
constexpr size_t WS_END = WS_RS + 65792;
static_assert((size_t)MROWS * NINC * 2 <= (size_t)MROWS * DFF * 2 + (size_t)MROWS * D * 2, "Z must fit in ACT+F");

struct Params { const float* in[26]; float* out; unsigned char* ws; int ph_lo, ph_hi; };

__device__ __forceinline__ unsigned cvt_pk_bf16(float lo, float hi) { unsigned r; asm volatile("v_cvt_pk_bf16_f32 %0, %1, %2" : "=v"(r) : "v"(lo), "v"(hi)); return r; }
__device__ __forceinline__ bf16_t f2bf(float x) { return (bf16_t)(cvt_pk_bf16(x, 0.f) & 0xffffu); }
__device__ __forceinline__ float bf2f(bf16_t h) { return __uint_as_float(((unsigned)h) << 16); }
__device__ __forceinline__ float bflo(unsigned w) { return __uint_as_float(w << 16); }
__device__ __forceinline__ float bfhi(unsigned w) { return __uint_as_float(w & 0xffff0000u); }
__device__ __forceinline__ float wave_sum(float v) {
#pragma unroll
    for (int o = 32; o >= 1; o >>= 1) v += __shfl_xor(v, o);
    return v;
}
template <int CTRL> __device__ __forceinline__ float dpp_f(float v) { return __builtin_bit_cast(float, __builtin_amdgcn_update_dpp(0, __builtin_bit_cast(int, v), CTRL, 0xf, 0xf, true)); }
__device__ __forceinline__ float row16_sum(float v) {
    v += dpp_f<0xB1>(v); v += dpp_f<0x4E>(v); v += dpp_f<0x141>(v); v += dpp_f<0x140>(v); return v;
}
__device__ __forceinline__ float wave64_sum(float v) {
    const float r = row16_sum(v); const int ri = __builtin_bit_cast(int, r);
    return __builtin_bit_cast(float, __builtin_amdgcn_readlane(ri, 0)) + __builtin_bit_cast(float, __builtin_amdgcn_readlane(ri, 16)) + __builtin_bit_cast(float, __builtin_amdgcn_readlane(ri, 32)) + __builtin_bit_cast(float, __builtin_amdgcn_readlane(ri, 48));
}
__device__ __forceinline__ float silu_f(float g) { return g * __builtin_amdgcn_rcpf(1.0f + __expf(-g)); }
__device__ __forceinline__ float sigmoid_f(float g) { return 1.0f / (1.0f + __expf(-g)); }
__device__ __forceinline__ float gelu_tanh_f(float y) { const float t = tanhf(0.7978845608028654f * (y + 0.044715f * y * y * y)); return 0.5f * y * (1.0f + t); }
__device__ __forceinline__ int zrow(int b, int s) { return s < NMETA ? MX + s : b * SEQ + (s - NMETA); }

namespace pg8 {
constexpr int BM = 256, BK = 64, HALF = 128, HTB = HALF * BK * 2, STAGE_BYTES = 8 * HTB, NXCD = 8, WGM = 8;
__device__ __forceinline__ int lds_byte(int r, int c) { const int st = (r >> 4) * 2 + (c >> 5), rr = r & 15, cc = c & 31, ob = rr * 64 + cc * 2; return st * 1024 + (ob ^ (((ob >> 9) & 1) << 5)); }
__device__ __forceinline__ void stage_rc(int b, int& R, int& C) { const int st = b / 1024, sb = b % 1024, swz = sb ^ (((sb >> 9) & 1) << 5); R = (st >> 1) * 16 + swz / 64; C = (st & 1) * 32 + (swz % 64) / 2; }
__device__ __forceinline__ int perm32(int rho) { const int n = rho >> 4, i = rho & 15; return 8 * (i >> 2) + 4 * n + (i & 3); }
struct Unit { int pm, pn; };
struct Gemm { const bf16_t* A; const bf16_t* Bt; int M, N, K; };
struct StaticOrder {
    int nM, nN, nwg, G, c;
    __device__ void init(int M, int N, int G_, int c_) { nM = M / BM; nN = N / BM; nwg = nM * nN; G = G_; c = c_; }
    __device__ bool next(int i, Unit& u) const {
        const long L = (long)i * G + c; if (L >= nwg) return false;
        int wgid = (int)L; { const int q = nwg / NXCD, r = nwg % NXCD, xcd = wgid % NXCD, off = wgid / NXCD; wgid = (xcd < r ? xcd * (q + 1) : r * (q + 1) + (xcd - r) * q) + off; }
        const int nig = WGM * nN, gid = wgid / nig, fm = gid * WGM, gsz = (nM - fm) < WGM ? (nM - fm) : WGM;
        u.pm = fm + ((wgid % nig) % gsz); u.pn = (wgid % nig) / gsz; return true;
    }
};
struct EpiBf16 {
    static constexpr bool PERM = true;
    bf16_t* O; int ldc; const float* rs;
    __device__ __forceinline__ void operator()(const f32x4 (&acc)[2][2][4][2], const Unit& u, int wr, int wc, int fr, int fq, const LAS float* rsl) const {
        const int row0 = u.pm * BM + wr * 64 + fr, col0 = u.pn * BM + wc * 32 + 8 * fq;
#pragma unroll
        for (int ai = 0; ai < 2; ++ai)
#pragma unroll
            for (int m = 0; m < 4; ++m) { bf16_t* rowp = O + (size_t)(row0 + ai * HALF + m * 16) * ldc + col0; const float sc = rs ? rsl[wr * 64 + fr + ai * HALF + m * 16] : 1.0f;
#pragma unroll
                for (int bj = 0; bj < 2; ++bj) { const f32x4 v0 = acc[ai][bj][m][0] * sc, v1 = acc[ai][bj][m][1] * sc;
                    u32x4 w; w.x = cvt_pk_bf16(v0[0], v0[1]); w.y = cvt_pk_bf16(v0[2], v0[3]); w.z = cvt_pk_bf16(v1[0], v1[1]); w.w = cvt_pk_bf16(v1[2], v1[3]);
                    *(u32x4*)(rowp + bj * HALF) = w; } }
    }
};
struct EpiSwiglu {
    static constexpr bool PERM = true;
    bf16_t* O; int ldc; const float* rs;
    __device__ __forceinline__ void operator()(const f32x4 (&acc)[2][2][4][2], const Unit& u, int wr, int wc, int fr, int fq, const LAS float* rsl) const {
        const int row0 = u.pm * BM + wr * 64 + fr, col0 = u.pn * HALF + wc * 32 + 8 * fq;
#pragma unroll
        for (int ai = 0; ai < 2; ++ai)
#pragma unroll
            for (int m = 0; m < 4; ++m) { bf16_t* rowp = O + (size_t)(row0 + ai * HALF + m * 16) * ldc + col0;
                const float sc = rsl[wr * 64 + fr + ai * HALF + m * 16], k1 = -1.4426950408889634f * sc, sc2 = sc * sc;
                const f32x4 g0 = acc[ai][0][m][0], g1 = acc[ai][0][m][1], u0 = acc[ai][1][m][0], u1 = acc[ai][1][m][1];
                float v[8];
#pragma unroll
                for (int j = 0; j < 4; ++j) { v[j] = (g0[j] * u0[j]) * (sc2 * __builtin_amdgcn_rcpf(1.0f + __builtin_amdgcn_exp2f(g0[j] * k1)));
                                              v[4 + j] = (g1[j] * u1[j]) * (sc2 * __builtin_amdgcn_rcpf(1.0f + __builtin_amdgcn_exp2f(g1[j] * k1))); }
                u32x4 w; w.x = cvt_pk_bf16(v[0], v[1]); w.y = cvt_pk_bf16(v[2], v[3]); w.z = cvt_pk_bf16(v[4], v[5]); w.w = cvt_pk_bf16(v[6], v[7]);
                *(u32x4*)rowp = w; }
    }
};

template <class Epi>
__device__ __forceinline__ void gemm_phase(LAS unsigned char* lds, const Gemm g, const StaticOrder& S, const Epi& E, const int tid) {
    const int wid = __builtin_amdgcn_readfirstlane(tid >> 6), lane = tid & 63, wr = wid >> 2, wc = wid & 3, fr = lane & 15, fq = lane >> 4;
    const int K = g.K, nt = K / BK;
    unsigned voffA[2], voffB[2];
#pragma unroll
    for (int i = 0; i < 2; ++i) { int R, C; stage_rc(tid * 16 + i * 8192, R, C); const int Rb = Epi::PERM ? ((R & ~31) + perm32(R & 31)) : R;
        voffA[i] = (unsigned)(R * K + C) * 2u; voffB[i] = (unsigned)(Rb * K + C) * 2u; }
    const size_t kstep = (size_t)(BK * 2);
    const size_t hstep = (size_t)HALF * K * 2;
    const size_t tstep = 2 * hstep;
    const unsigned ldsw = (unsigned)wid * 1024u;
    const int aoff = lds_byte(wr * 64 + fr, fq * 8), boff = lds_byte(wc * 32 + fr, fq * 8);
#define PG8_SA(b, h) (((b) * 2 + (h)) * HTB)
#define PG8_SB(b, h) ((4 + (b) * 2 + (h)) * HTB)
#define PG8_STAGE(bufoff, gbase, voff) do { _Pragma("unroll") for (int _i = 0; _i < 2; ++_i) \
        __builtin_amdgcn_global_load_lds((const unsigned*)((const char*)(gbase) + (voff)[_i]), (LAS unsigned*)(lds + (bufoff) + ldsw + _i * 8192), 16, 0, 0); } while (0)
#define PG8_LDA(dst, b, h) do { _Pragma("unroll") for (int m = 0; m < 4; ++m) _Pragma("unroll") for (int k = 0; k < 2; ++k) dst[m][k] = *(const LAS bf16x8*)(lds + PG8_SA(b, h) + aoff + m * 2048 + k * 1024); } while (0)
#define PG8_LDB(dst, b, h) do { _Pragma("unroll") for (int n = 0; n < 2; ++n) _Pragma("unroll") for (int k = 0; k < 2; ++k) dst[n][k] = *(const LAS bf16x8*)(lds + PG8_SB(b, h) + boff + n * 2048 + k * 1024); } while (0)
#define PG8_MMA(ai, bj, At, Bt) do { __builtin_amdgcn_s_setprio(1); _Pragma("unroll") for (int m = 0; m < 4; ++m) _Pragma("unroll") for (int n = 0; n < 2; ++n) _Pragma("unroll") for (int k = 0; k < 2; ++k) \
        acc[ai][bj][m][n] = __builtin_amdgcn_mfma_f32_16x16x32_bf16(Bt[n][k], At[m][k], acc[ai][bj][m][n], 0, 0, 0); __builtin_amdgcn_s_setprio(0); } while (0)
#define PG8_WAIT_V(n) asm volatile("s_waitcnt vmcnt(" #n ")" ::: "memory")
#define PG8_WAIT_L(n) asm volatile("s_waitcnt lgkmcnt(" #n ")" ::: "memory")
#define PG8_BAR __builtin_amdgcn_s_barrier()
#define PG8_SCHED __builtin_amdgcn_sched_barrier(0)
    Unit cur, nxt; int ui = 0;
    LAS float* rsl = (LAS float*)(lds + LDS_RS_OFF);
    if (E.rs) { Unit uu; for (int i = 0; i < LDS_RS_UNITS && S.next(i, uu); ++i) if (tid < 256) rsl[i * 256 + tid] = E.rs[uu.pm * BM + tid]; }
    __syncthreads();
    if (!S.next(0, cur)) return;
    f32x4 acc[2][2][4][2];
#pragma unroll
    for (int a = 0; a < 2; ++a)
#pragma unroll
        for (int b = 0; b < 2; ++b)
#pragma unroll
            for (int m = 0; m < 4; ++m)
#pragma unroll
                for (int n = 0; n < 2; ++n) acc[a][b][m][n] = (f32x4){0.f, 0.f, 0.f, 0.f};
    bf16x8 At[4][2], B0[2][2], B1[2][2];
    const char* cA = (const char*)g.A + (size_t)cur.pm * tstep; const char* cB = (const char*)g.Bt + (size_t)cur.pn * tstep;
    PG8_STAGE(PG8_SB(0, 0), cB, voffB); PG8_STAGE(PG8_SA(0, 0), cA, voffA); PG8_STAGE(PG8_SB(0, 1), cB + hstep, voffB); PG8_STAGE(PG8_SA(0, 1), cA + hstep, voffA);
    if (wr == 1) PG8_BAR;
    PG8_WAIT_V(4); PG8_BAR;
    PG8_STAGE(PG8_SB(1, 0), cB + kstep, voffB); PG8_STAGE(PG8_SA(1, 0), cA + kstep, voffA); PG8_STAGE(PG8_SB(1, 1), cB + hstep + kstep, voffB);
    PG8_WAIT_V(6); PG8_BAR;
    for (;;) {
        const bool has_next = S.next(ui + 1, nxt);
        const char* nA = has_next ? (const char*)g.A + (size_t)nxt.pm * tstep : cA; const char* nB = has_next ? (const char*)g.Bt + (size_t)nxt.pn * tstep : cB;
        for (int t = 0; t < nt; t += 2) {
            const bool last = (t == nt - 2);
            const char* a1 = cA + (size_t)(t + 1) * kstep;
            const char* a2 = last ? nA : cA + (size_t)(t + 2) * kstep; const char* b2 = last ? nB : cB + (size_t)(t + 2) * kstep;
            const char* a3 = a2 + kstep; const char* b3 = b2 + kstep;
            PG8_LDB(B0, 0, 0); PG8_SCHED; PG8_LDA(At, 0, 0); PG8_STAGE(PG8_SA(1, 1), a1 + hstep, voffA);
            PG8_WAIT_L(8); PG8_BAR; PG8_WAIT_L(0); PG8_MMA(0, 0, At, B0); PG8_BAR; PG8_SCHED;
            PG8_LDB(B1, 0, 1); PG8_STAGE(PG8_SB(0, 0), b2, voffB);
            PG8_BAR; PG8_WAIT_L(0); PG8_MMA(0, 1, At, B1); PG8_BAR;
            PG8_LDA(At, 0, 1); PG8_STAGE(PG8_SA(0, 0), a2, voffA);
            PG8_BAR; PG8_WAIT_L(0); PG8_MMA(1, 0, At, B0); PG8_BAR; PG8_SCHED;
            PG8_STAGE(PG8_SB(0, 1), b2 + hstep, voffB);
            PG8_WAIT_V(6); PG8_BAR; PG8_MMA(1, 1, At, B1); PG8_BAR;
            PG8_LDB(B0, 1, 0); PG8_SCHED; PG8_LDA(At, 1, 0); PG8_STAGE(PG8_SA(0, 1), a2 + hstep, voffA);
            PG8_WAIT_L(8); PG8_BAR; PG8_WAIT_L(0); PG8_MMA(0, 0, At, B0); PG8_BAR; PG8_SCHED;
            PG8_LDB(B1, 1, 1); PG8_STAGE(PG8_SB(1, 0), b3, voffB);
            PG8_BAR; PG8_WAIT_L(0); PG8_MMA(0, 1, At, B1); PG8_BAR;
            PG8_LDA(At, 1, 1); PG8_STAGE(PG8_SA(1, 0), a3, voffA);
            PG8_BAR; PG8_WAIT_L(0); PG8_MMA(1, 0, At, B0); PG8_BAR; PG8_SCHED;
            PG8_STAGE(PG8_SB(1, 1), b3 + hstep, voffB);
            PG8_WAIT_V(6); PG8_BAR; PG8_MMA(1, 1, At, B1); PG8_BAR;
        }
        E(acc, cur, wr, wc, fr, fq, rsl + ui * 256);
        if (!has_next) break;
#pragma unroll
        for (int a = 0; a < 2; ++a)
#pragma unroll
            for (int b = 0; b < 2; ++b)
#pragma unroll
                for (int m = 0; m < 4; ++m)
#pragma unroll
                    for (int n = 0; n < 2; ++n) acc[a][b][m][n] = (f32x4){0.f, 0.f, 0.f, 0.f};
        cur = nxt; cA = nA; cB = nB; ++ui;
    }
    PG8_WAIT_V(0);
    if (wr == 0) PG8_BAR;
    PG8_BAR;
#undef PG8_SA
#undef PG8_SB
#undef PG8_STAGE
#undef PG8_LDA
#undef PG8_LDB
#undef PG8_MMA
#undef PG8_WAIT_V
#undef PG8_WAIT_L
#undef PG8_BAR
#undef PG8_SCHED
}
}

__device__ __forceinline__ void skinny16(LAS unsigned char* lds, const bf16_t* A, int K, const bf16_t* Bt, int ntiles, int mode, bf16_t* O, int ldo, const float* rs, const int tid, const int bid) {
    const int wid = __builtin_amdgcn_readfirstlane(tid >> 6), lane = tid & 63, fr = lane & 15, fq = lane >> 4;
    LAS f32x4* RED = (LAS f32x4*)lds;
    const int nsteps = K / 32;
    for (int tile = (int)gridDim.x - 1 - bid; tile < ntiles; tile += gridDim.x) {
        const int c0 = 16 * tile, rb0 = mode ? ((c0 >> 7) * 256 + (c0 & 127)) : c0;
        f32x4 acc0 = (f32x4){0.f, 0.f, 0.f, 0.f}, acc1 = (f32x4){0.f, 0.f, 0.f, 0.f};
        const bf16_t* ap = A + (size_t)fr * K + fq * 8;
        const bf16_t* bp0 = Bt + (size_t)(rb0 + fr) * K + fq * 8;
        const bf16_t* bp1 = bp0 + (size_t)128 * K;
        for (int s = wid; s < nsteps; s += 32) {
            bf16x8 a[4], b0[4], b1[4];
#pragma unroll
            for (int j = 0; j < 4; ++j) { const int sj = s + 8 * j, sc = sj < nsteps ? sj : s;
                a[j] = *(const bf16x8*)(ap + sc * 32); b0[j] = *(const bf16x8*)(bp0 + sc * 32); if (mode) b1[j] = *(const bf16x8*)(bp1 + sc * 32); }
#pragma unroll
            for (int j = 0; j < 4; ++j) if (s + 8 * j < nsteps) {
                acc0 = __builtin_amdgcn_mfma_f32_16x16x32_bf16(b0[j], a[j], acc0, 0, 0, 0);
                if (mode) acc1 = __builtin_amdgcn_mfma_f32_16x16x32_bf16(b1[j], a[j], acc1, 0, 0, 0); }
        }
        RED[(wid * 2 + 0) * 64 + lane] = acc0; RED[(wid * 2 + 1) * 64 + lane] = acc1;
        __syncthreads();
        if (wid == 0) {
            f32x4 s0 = (f32x4){0.f, 0.f, 0.f, 0.f}, s1 = s0;
#pragma unroll
            for (int w = 0; w < 8; ++w) { s0 += RED[(w * 2 + 0) * 64 + lane]; s1 += RED[(w * 2 + 1) * 64 + lane]; }
            if (rs) { const float sc = rs[fr]; s0 *= sc; s1 *= sc; }
            if (mode) {
#pragma unroll
                for (int j = 0; j < 4; ++j) s0[j] = silu_f(s0[j]) * s1[j];
            }
            u32x2 w; w.x = cvt_pk_bf16(s0[0], s0[1]); w.y = cvt_pk_bf16(s0[2], s0[3]);
            *(u32x2*)(O + (size_t)fr * ldo + c0 + 4 * fq) = w;
        }
        __syncthreads();
    }
}

struct TileDesc { const float* src; bf16_t* dst; const float* g; int N, K; };
__device__ __forceinline__ TileDesc decode_tile(const Params& p, int g) {
    const float* W; bf16_t* out; const float* gn = nullptr; int K, N, mode, loc;
    if (g < 688)       { W = p.in[3];  out = (bf16_t*)(p.ws + WS_W1A); K = D;   N = DFF;  mode = 1; loc = g; gn = p.in[2]; }
    else if (g < 1376) { W = p.in[4];  out = (bf16_t*)(p.ws + WS_W1A); K = D;   N = DFF;  mode = 2; loc = g - 688; gn = p.in[2]; }
    else if (g < 2064) { W = p.in[5];  out = (bf16_t*)(p.ws + WS_W1B); K = DFF; N = D;    mode = 0; loc = g - 1376; }
    else if (g < 2704) { W = p.in[8];  out = (bf16_t*)(p.ws + WS_WIN); K = D;   N = NINC; mode = 0; loc = g - 2064; gn = p.in[7]; }
    else if (g < 2960) { W = p.in[19]; out = (bf16_t*)(p.ws + WS_WOUT); K = D;  N = D;    mode = 0; loc = g - 2704; }
    else if (g < 3648) { W = p.in[22]; out = (bf16_t*)(p.ws + WS_W2A); K = D;   N = DFF;  mode = 1; loc = g - 2960; gn = p.in[21]; }
    else if (g < 4336) { W = p.in[23]; out = (bf16_t*)(p.ws + WS_W2A); K = D;   N = DFF;  mode = 2; loc = g - 3648; gn = p.in[21]; }
    else               { W = p.in[24]; out = (bf16_t*)(p.ws + WS_W2B); K = DFF; N = D;    mode = 0; loc = g - 4336; }
    const int nNt = N / 128, kt = loc / nNt, ntl = loc % nNt;
    const int rowbase = mode == 0 ? ntl * 128 : ntl * 256 + (mode == 2 ? 128 : 0);
    TileDesc t; t.src = W + (size_t)(kt * 128) * N + ntl * 128; t.dst = out + (size_t)rowbase * K + kt * 128; t.g = gn ? gn + kt * 128 : nullptr; t.N = N; t.K = K; return t;
}
constexpr int PREP_TILES = 5024;
__device__ __forceinline__ void prep_weights(const Params& p, LAS unsigned char* lds, const int tid, const int bid) {
    LAS float* T = (LAS float*)lds;
    const int r = tid >> 5, c4 = tid & 31;
    int g = bid;
    if (g >= PREP_TILES) return;
    TileDesc td = decode_tile(p, g);
    f32x4 v[8];
#pragma unroll
    for (int i = 0; i < 8; ++i) v[i] = *(const f32x4*)(td.src + (size_t)(r + 16 * i) * td.N + 4 * c4);
    for (;;) {
#pragma unroll
        for (int i = 0; i < 8; ++i) { const int k = r + 16 * i; *(LAS f32x4*)(T + k * 132 + 4 * (c4 ^ ((k >> 3) & 7))) = v[i]; }
        __syncthreads();
        const int gn = g + gridDim.x; const bool has_next = gn < PREP_TILES;
        TileDesc tn = td;
        if (has_next) { tn = decode_tile(p, gn);
#pragma unroll
            for (int i = 0; i < 8; ++i) v[i] = *(const f32x4*)(tn.src + (size_t)(r + 16 * i) * tn.N + 4 * c4); }
#pragma unroll
        for (int p2 = 0; p2 < 4; ++p2) { const int cch = tid & 15, nn = (tid >> 4) + 32 * p2, k8 = 8 * cch, ncol = nn ^ (4 * (cch & 7)); float x[8];
#pragma unroll
            for (int i = 0; i < 8; ++i) x[i] = T[(k8 + i) * 132 + ncol];
            if (td.g) { const f32x4 g0 = *(const f32x4*)(td.g + k8), g1 = *(const f32x4*)(td.g + k8 + 4);
                x[0] *= g0[0]; x[1] *= g0[1]; x[2] *= g0[2]; x[3] *= g0[3]; x[4] *= g1[0]; x[5] *= g1[1]; x[6] *= g1[2]; x[7] *= g1[3]; }
            u32x4 w; w.x = cvt_pk_bf16(x[0], x[1]); w.y = cvt_pk_bf16(x[2], x[3]); w.z = cvt_pk_bf16(x[4], x[5]); w.w = cvt_pk_bf16(x[6], x[7]);
            *(u32x4*)(td.dst + (size_t)nn * td.K + k8) = w; }
        __syncthreads();
        if (!has_next) break;
        g = gn; td = tn;
    }
}

template <bool HX> struct EwRows { f32x4 hf[HX ? 2 : 1][HX ? 8 : 1]; u32x2 hw[HX ? 1 : 2][HX ? 1 : 8]; u32x2 fw[HX ? 1 : 2][HX ? 1 : 8]; int rr[2]; };
template <bool HX> __device__ __forceinline__ void ew_load(EwRows<HX>& R, int r0, int nw, int nrows, const bf16_t* F, const float* hx, const float* meta, const bf16_t* hb, int lane) {
    R.rr[0] = r0; R.rr[1] = (r0 + nw < nrows) ? r0 + nw : r0;
#pragma unroll
    for (int q = 0; q < 2; ++q) { const int r = R.rr[q];
        if constexpr (HX) { const float* hp = r < MX ? hx + (size_t)r * D : meta + (size_t)(r - MX) * D;
#pragma unroll
            for (int i = 0; i < 8; ++i) R.hf[q][i] = *(const f32x4*)(hp + i * 256 + lane * 4); }
        else {
#pragma unroll
            for (int i = 0; i < 8; ++i) R.hw[q][i] = *(const u32x2*)(hb + (size_t)r * D + i * 256 + lane * 4);
#pragma unroll
            for (int i = 0; i < 8; ++i) R.fw[q][i] = *(const u32x2*)(F + (size_t)r * D + i * 256 + lane * 4); } }
}
template <bool HX> __device__ __forceinline__ void ew_phase(const bf16_t* F, float coef, const float* gpost, const float* hx, const float* meta, const bf16_t* hb, float* out32, bf16_t* hbo, float* rso, int nrows, const int tid, const int bid) {
    const int lane = tid & 63, gw = bid * 8 + (tid >> 6), nw = gridDim.x * 8;
    if (gw >= nrows) return;
    EwRows<HX> R; ew_load<HX>(R, gw, nw, nrows, F, hx, meta, hb, lane);
    for (int r0 = gw; r0 < nrows; r0 += 2 * nw) {
        EwRows<HX> Nx; const bool has_next = r0 + 2 * nw < nrows;
        if (has_next) ew_load<HX>(Nx, r0 + 2 * nw, nw, nrows, F, hx, meta, hb, lane);
#pragma unroll
        for (int q = 0; q < 2; ++q) { const int r = R.rr[q];
            f32x4 h[8];
#pragma unroll
            for (int i = 0; i < 8; ++i) { if constexpr (HX) h[i] = R.hf[q][i]; else { const u32x2 w = R.hw[q][i]; h[i] = (f32x4){bflo(w.x), bfhi(w.x), bflo(w.y), bfhi(w.y)}; } }
            if constexpr (!HX) {
                f32x4 f[8]; float ss = 0.f;
#pragma unroll
                for (int i = 0; i < 8; ++i) { const u32x2 w = R.fw[q][i]; f[i] = (f32x4){bflo(w.x), bfhi(w.x), bflo(w.y), bfhi(w.y)}; ss += (f[i][0] * f[i][0] + f[i][1] * f[i][1]) + (f[i][2] * f[i][2] + f[i][3] * f[i][3]); }
                ss = wave64_sum(ss);
                const float rs = coef * rsqrtf(ss * (1.0f / D) + EPS);
#pragma unroll
                for (int i = 0; i < 8; ++i) { const f32x4 g = *(const f32x4*)(gpost + i * 256 + lane * 4); h[i] += f[i] * rs * g; }
            }
            if (out32 && r < MX) {
#pragma unroll
                for (int i = 0; i < 8; ++i) *(f32x4*)(out32 + (size_t)r * D + i * 256 + lane * 4) = h[i];
            }
            if (hbo) {
                float ss = 0.f;
#pragma unroll
                for (int i = 0; i < 8; ++i) ss += (h[i][0] * h[i][0] + h[i][1] * h[i][1]) + (h[i][2] * h[i][2] + h[i][3] * h[i][3]);
                ss = wave64_sum(ss);
                if (lane == 0) rso[r] = rsqrtf(ss * (1.0f / D) + EPS);
#pragma unroll
                for (int i = 0; i < 8; ++i) { u32x2 w; w.x = cvt_pk_bf16(h[i][0], h[i][1]); w.y = cvt_pk_bf16(h[i][2], h[i][3]);
                    *(u32x2*)(hbo + (size_t)r * D + i * 256 + lane * 4) = w; }
            }
        }
        if (has_next) R = Nx;
    }
}

constexpr int L_XIN = 0, L_XC = 17152, L_AA = L_XC + 16640, L_UU = L_AA + 16640, L_XCB = L_UU + 16640, L_WA = L_XCB + 9216, L_WX = L_WA + 9216, L_PART = L_WX + 9216, L_END = L_PART + 4096;
static_assert(L_END <= LDS_MAIN, "mixer LDS");
constexpr int NRUN = 16;
struct HeadConst { float cw0, cw1, cw2, cw3, cb, go; float sp[8], ba[8], bx[8]; };
__device__ __forceinline__ void lru_load_head(const Params& p, LAS unsigned char* lds, int h, const int tid, HeadConst& hc) {
    LAS bf16_t* WA = (LAS bf16_t*)(lds + L_WA); LAS bf16_t* WX = (LAS bf16_t*)(lds + L_WX);
    const float* wa = p.in[11] + (size_t)h * 4096; const float* wx = p.in[13] + (size_t)h * 4096;
    for (int e = tid; e < 4096; e += 512) { const int i = e >> 6, j = e & 63; WA[j * 72 + i] = f2bf(wa[e]); WX[j * 72 + i] = f2bf(wx[e]); }
    const int lane = tid & 63, wid = tid >> 6, fq = lane >> 4, nh = wid >> 2, ch = 64 * h + lane;
    hc.cw0 = p.in[9][ch]; hc.cw1 = p.in[9][DL + ch]; hc.cw2 = p.in[9][2 * DL + ch]; hc.cw3 = p.in[9][3 * DL + ch]; hc.cb = p.in[10][ch]; hc.go = p.in[17][ch];
#pragma unroll
    for (int k = 0; k < 8; ++k) { const int c2 = 64 * h + 16 * (2 * nh + (k >> 2)) + 4 * fq + (k & 3);
        hc.sp[k] = -8.0f * log1pf(__expf(-p.in[15][c2])); hc.ba[k] = p.in[12][c2]; hc.bx[k] = p.in[14][c2]; }
}
struct XinRegs { u32x4 a, b; };
__device__ __forceinline__ void xin_prefetch(const bf16_t* Z, int b, int h, int v, const int tid, XinRegs& x) {
    const int s0 = v < 0 ? 0 : NMETA + 64 * v, ntok = v < 0 ? NMETA : 64;
    x.a = (u32x4){0u, 0u, 0u, 0u}; x.b = x.a;
    { const int row = tid >> 3, seg = tid & 7, s = s0 - 3 + row; if (s >= 0 && row < ntok + 3) x.a = *(const u32x4*)(Z + (size_t)zrow(b, s) * NINC + DL + 64 * h + 8 * seg); }
    if (tid < 24) { const int e = 512 + tid, row = e >> 3, seg = e & 7, s = s0 - 3 + row; if (s >= 0 && row < ntok + 3) x.b = *(const u32x4*)(Z + (size_t)zrow(b, s) * NINC + DL + 64 * h + 8 * seg); }
}
__device__ __forceinline__ void xin_store(LAS float* XIN, const int tid, const XinRegs& x) {
    { LAS float* d = XIN + tid * 8; *(LAS f32x4*)d = (f32x4){bflo(x.a.x), bfhi(x.a.x), bflo(x.a.y), bfhi(x.a.y)}; *(LAS f32x4*)(d + 4) = (f32x4){bflo(x.a.z), bfhi(x.a.z), bflo(x.a.w), bfhi(x.a.w)}; }
    if (tid < 24) { LAS float* d = XIN + (512 + tid) * 8; *(LAS f32x4*)d = (f32x4){bflo(x.b.x), bfhi(x.b.x), bflo(x.b.y), bfhi(x.b.y)}; *(LAS f32x4*)(d + 4) = (f32x4){bflo(x.b.z), bfhi(x.b.z), bflo(x.b.w), bfhi(x.b.w)}; }
}
__device__ __forceinline__ void lru_tile_math(LAS unsigned char* lds, const int tid, const HeadConst& hc) {
    const int wid = __builtin_amdgcn_readfirstlane(tid >> 6), lane = tid & 63, fr = lane & 15, fq = lane >> 4;
    LAS float* XIN = (LAS float*)(lds + L_XIN); LAS float* XC = (LAS float*)(lds + L_XC); LAS float* AA = (LAS float*)(lds + L_AA); LAS float* UU = (LAS float*)(lds + L_UU);
    LAS bf16_t* XCB = (LAS bf16_t*)(lds + L_XCB); LAS bf16_t* WA = (LAS bf16_t*)(lds + L_WA); LAS bf16_t* WX = (LAS bf16_t*)(lds + L_WX);
    { const int c = lane;
#pragma unroll
      for (int q = 0; q < 8; ++q) { const int t = wid + 8 * q;
          const float xc = hc.cb + hc.cw0 * XIN[t * 64 + c] + hc.cw1 * XIN[(t + 1) * 64 + c] + hc.cw2 * XIN[(t + 2) * 64 + c] + hc.cw3 * XIN[(t + 3) * 64 + c];
          XC[t * 65 + c] = xc; XCB[t * 72 + c] = f2bf(xc); } }
    __syncthreads();
    { const int mt = wid & 3, nh = wid >> 2, tok = 16 * mt + fr;
#pragma unroll
      for (int nbi = 0; nbi < 2; ++nbi) { const int nb = 2 * nh + nbi;
          f32x4 ga = (f32x4){0.f, 0.f, 0.f, 0.f}, gx = ga;
#pragma unroll
          for (int ks = 0; ks < 2; ++ks) {
              const bf16x8 xf = *(const LAS bf16x8*)(XCB + tok * 72 + 32 * ks + 8 * fq);
              const bf16x8 waf = *(const LAS bf16x8*)(WA + (16 * nb + fr) * 72 + 32 * ks + 8 * fq);
              const bf16x8 wxf = *(const LAS bf16x8*)(WX + (16 * nb + fr) * 72 + 32 * ks + 8 * fq);
              ga = __builtin_amdgcn_mfma_f32_16x16x32_bf16(waf, xf, ga, 0, 0, 0);
              gx = __builtin_amdgcn_mfma_f32_16x16x32_bf16(wxf, xf, gx, 0, 0, 0); }
#pragma unroll
          for (int r = 0; r < 4; ++r) { const int col = 16 * nb + 4 * fq + r, k = nbi * 4 + r;
              const float a_g = __builtin_amdgcn_rcpf(1.0f + __expf(-(ga[r] + hc.ba[k]))), x_g = __builtin_amdgcn_rcpf(1.0f + __expf(-(gx[r] + hc.bx[k])));
              const float la = a_g * hc.sp[k];
              const float a = __expf(la), x2 = 2.0f * la;
              const float ser = -x2 * (1.0f + x2 * (0.5f + x2 * (0.16666667f + x2 * (0.041666668f + x2 * (0.0083333338f + x2 * 0.0013888889f)))));
              const float om = x2 > -0.25f ? ser : 1.0f - a * a;
              AA[tok * 65 + col] = a; UU[tok * 65 + col] = __builtin_amdgcn_sqrtf(om) * x_g * XC[tok * 65 + col]; } } }
    __syncthreads();
}
__device__ __forceinline__ void mixer_lru_scan(const Params& p, LAS unsigned char* lds, const int tid, const int bid) {
    const int wid = __builtin_amdgcn_readfirstlane(tid >> 6), lane = tid & 63;
    LAS float* XIN = (LAS float*)(lds + L_XIN); LAS float* AA = (LAS float*)(lds + L_AA); LAS float* UU = (LAS float*)(lds + L_UU); LAS float* PART = (LAS float*)(lds + L_PART);
    float* RSA = (float*)(p.ws + WS_SUMA); float* RSH = (float*)(p.ws + WS_SUMH);
    const bf16_t* Z = (const bf16_t*)(p.ws + WS_Z); unsigned* HP = (unsigned*)(p.ws + WS_F);
    int hl = -1; HeadConst hc;
    for (int it = bid; it < NBATCH * 16 * NRUN; it += gridDim.x) {
        const int h = it & 15, b = it >> 8, run = ((it >> 4) + b) & 15, ch = 64 * h + lane;
        if (h != hl) { lru_load_head(p, lds, h, tid, hc); hl = h; }
        const int v0 = run == 0 ? -1 : 4 * run, v1 = 4 * run + 4;
        float cinH = 0.f, cinA = 1.f;
        XinRegs xr; xin_prefetch(Z, b, h, v0, tid, xr);
        for (int v = v0; v < v1; ++v) {
            const int ntok = v < 0 ? NMETA : 64;
            xin_store(XIN, tid, xr);
            __syncthreads();
            if (v + 1 < v1) xin_prefetch(Z, b, h, v + 1, tid, xr);
            lru_tile_math(lds, tid, hc);
            float a[8], u[8]; float A = 1.f, H = 0.f;
#pragma unroll
            for (int i = 0; i < 8; ++i) { const int t = 8 * wid + i; a[i] = AA[t * 65 + lane]; u[i] = UU[t * 65 + lane]; if (t < ntok) { H = a[i] * H + u[i]; A *= a[i]; } }
            PART[(wid * 2 + 0) * 64 + lane] = A; PART[(wid * 2 + 1) * 64 + lane] = H;
            __syncthreads();
            float hcur = cinH, pcur = cinA;
#pragma unroll
            for (int w = 0; w < 8; ++w) { const float pa = PART[(w * 2 + 0) * 64 + lane], ph = PART[(w * 2 + 1) * 64 + lane]; cinH = pa * cinH + ph; cinA *= pa; if (w < wid) { hcur = pa * hcur + ph; pcur *= pa; } }
            if (v >= 0) {
                unsigned* hp = HP + ((size_t)b * SEQ + 64 * v + 8 * wid) * DL + ch;
#pragma unroll
                for (int i = 0; i < 8; ++i) { hcur = a[i] * hcur + u[i]; pcur *= a[i]; hp[(size_t)i * DL] = cvt_pk_bf16(hcur, pcur); }
            }
        }
        if (wid == 0) { RSA[(size_t)(b * NRUN + run) * DL + ch] = cinA; RSH[(size_t)(b * NRUN + run) * DL + ch] = cinH; }
    }
}
__device__ __forceinline__ void mixer_lru_out(const Params& p, const int tid, const int bid) {
    const int wid = tid >> 6, lane = tid & 63;
    const float* RSA = (const float*)(p.ws + WS_SUMA); const float* RSH = (const float*)(p.ws + WS_SUMH);
    const bf16_t* Z = (const bf16_t*)(p.ws + WS_Z); const unsigned* HP = (const unsigned*)(p.ws + WS_F); bf16_t* MIX = (bf16_t*)p.out;
    for (int wi = bid * 8 + wid; wi < NBATCH * NRUN * 8 * 4; wi += gridDim.x * 8) {
        const int q = wi & 3, chunk = (wi >> 2) & 7, run = (wi >> 5) & 15, b = wi >> 9, col = 256 * q + 4 * lane;
        f32x4 cin = (f32x4){0.f, 0.f, 0.f, 0.f};
        { f32x4 sa[NRUN - 1], sh[NRUN - 1];
#pragma unroll
          for (int rr = 0; rr < NRUN - 1; ++rr) { const size_t o = (size_t)(b * NRUN + (rr < run ? rr : 0)) * DL + col; sa[rr] = *(const f32x4*)(RSA + o); sh[rr] = *(const f32x4*)(RSH + o); }
#pragma unroll
          for (int rr = 0; rr < NRUN - 1; ++rr) if (rr < run) cin = sa[rr] * cin + sh[rr]; }
        const f32x4 go = *(const f32x4*)(p.in[17] + col);
        const size_t row0 = (size_t)b * SEQ + 256 * run + 32 * chunk;
#pragma unroll 8
        for (int i = 0; i < 32; ++i) { const size_t row = row0 + i;
            const u32x4 hp = *(const u32x4*)(HP + row * DL + col);
            const u32x2 yw = *(const u32x2*)(Z + row * NINC + col);
            const f32x4 hh = (f32x4){bflo(hp.x) + bfhi(hp.x) * cin[0], bflo(hp.y) + bfhi(hp.y) * cin[1], bflo(hp.z) + bfhi(hp.z) * cin[2], bflo(hp.w) + bfhi(hp.w) * cin[3]};
            const f32x4 y = (f32x4){bflo(yw.x), bfhi(yw.x), bflo(yw.y), bfhi(yw.y)};
            f32x4 vv;
#pragma unroll
            for (int k = 0; k < 4; ++k) { const float z2 = y[k] * (1.5957691216057308f + 0.07135481627f * y[k] * y[k]);
                vv[k] = hh[k] * y[k] * __builtin_amdgcn_rcpf(1.0f + __expf(-z2)); }
            const float ss = row16_sum((vv[0] * vv[0] + vv[1] * vv[1]) + (vv[2] * vv[2] + vv[3] * vv[3]));
            const f32x4 r = vv * __builtin_amdgcn_rsqf(ss * (1.0f / 64.0f) + EPS) * go;
            u32x2 w; w.x = cvt_pk_bf16(r[0], r[1]); w.y = cvt_pk_bf16(r[2], r[3]);
            *(u32x2*)(MIX + row * D + col) = w; }
    }
}
__device__ __forceinline__ void mixer_sconv(const Params& p, const int tid, const int bid) {
    const int wid = tid >> 6, lane = tid & 63;
    const bf16_t* Z = (const bf16_t*)(p.ws + WS_Z); bf16_t* MIX = (bf16_t*)p.out;
    for (int wi = bid * 8 + wid; wi < NBATCH * 128 * 4; wi += gridDim.x * 8) {
        const int q = wi & 3, c32 = (wi >> 2) & 127, b = wi >> 9, col = 256 * q + 4 * lane;
        const f32x4 w0 = *(const f32x4*)(p.in[16] + col), w1 = *(const f32x4*)(p.in[16] + DL + col), w2 = *(const f32x4*)(p.in[16] + 2 * DL + col), gg = *(const f32x4*)(p.in[18] + col);
        const int t0 = 32 * c32, s = NMETA + t0;
        f32x4 cvm2, cvm1;
        { const size_t r2 = (size_t)zrow(b, s - 2) * NINC + col, r1 = (size_t)zrow(b, s - 1) * NINC + col;
          const u32x2 c2 = *(const u32x2*)(Z + r2 + 3 * DL), v2 = *(const u32x2*)(Z + r2 + 4 * DL), c1 = *(const u32x2*)(Z + r1 + 3 * DL), v1 = *(const u32x2*)(Z + r1 + 4 * DL);
          cvm2 = (f32x4){bflo(c2.x) * bflo(v2.x), bfhi(c2.x) * bfhi(v2.x), bflo(c2.y) * bflo(v2.y), bfhi(c2.y) * bfhi(v2.y)};
          cvm1 = (f32x4){bflo(c1.x) * bflo(v1.x), bfhi(c1.x) * bfhi(v1.x), bflo(c1.y) * bflo(v1.y), bfhi(c1.y) * bfhi(v1.y)}; }
#pragma unroll 8
        for (int i = 0; i < 32; ++i) { const size_t row = (size_t)b * SEQ + t0 + i; const size_t zr = row * NINC + col;
            const u32x2 cw = *(const u32x2*)(Z + zr + 3 * DL), vw = *(const u32x2*)(Z + zr + 4 * DL), bw = *(const u32x2*)(Z + zr + 2 * DL);
            const f32x4 cv0 = (f32x4){bflo(cw.x) * bflo(vw.x), bfhi(cw.x) * bfhi(vw.x), bflo(cw.y) * bflo(vw.y), bfhi(cw.y) * bfhi(vw.y)};
            const f32x4 bs = (f32x4){bflo(bw.x), bfhi(bw.x), bflo(bw.y), bfhi(bw.y)};
            const f32x4 o = bs * (w0 * cvm2 + w1 * cvm1 + w2 * cv0);
            const float ss = row16_sum((o[0] * o[0] + o[1] * o[1]) + (o[2] * o[2] + o[3] * o[3]));
            const f32x4 r = o * (rsqrtf(ss * (1.0f / 64.0f) + EPS)) * gg;
            u32x2 w; w.x = cvt_pk_bf16(r[0], r[1]); w.y = cvt_pk_bf16(r[2], r[3]);
            *(u32x2*)(MIX + row * D + DL + col) = w;
            cvm2 = cvm1; cvm1 = cv0; }
    }
}

#define XB_TMO      128
#define XB_XCNT(j)  (256  + 64 * (j))
#define XB_XSUB(j)  (1280 + 64 * (j))
#define XB_XGEN(j)  (2304 + 64 * (j))
#define XB_TOP      3328
#define XB_TOPGEN   3392
#define XCD_BAR_WORDS 3456
#define XB_SPIN_CAP (1u << 20)
__device__ __forceinline__ unsigned xb_ld(unsigned* p)              { return __hip_atomic_load(p, __ATOMIC_RELAXED, __HIP_MEMORY_SCOPE_AGENT); }
__device__ __forceinline__ unsigned xb_add(unsigned* p, unsigned v) { return __hip_atomic_fetch_add(p, v, __ATOMIC_RELAXED, __HIP_MEMORY_SCOPE_AGENT); }
__device__ __forceinline__ unsigned xb_xcc_id() { return (unsigned)__builtin_amdgcn_s_getreg((3 << 11) | 20) & 0xFu; }
#define XB_SPIN(cond, bar) do { unsigned _sp = 0; while (cond) { __builtin_amdgcn_s_sleep(1); \
    if ((++_sp & 255u) == 0u) { if (xb_ld(&(bar)[XB_TMO])) break; if (_sp > XB_SPIN_CAP) { atomicAdd(&(bar)[XB_TMO], 1u); break; } } } } while (0)
struct XcdBarrier { unsigned* bar; unsigned x; volatile LAS unsigned* st; };
__device__ __forceinline__ XcdBarrier xcd_barrier_post(unsigned* bar, volatile LAS unsigned* st) {
    XcdBarrier b; b.bar = bar; b.x = xb_xcc_id(); b.st = st;
    if (threadIdx.x == 0) (void)xb_add(&bar[XB_XCNT(b.x)], 1u);
    return b;
}
__device__ __forceinline__ void xcd_barrier_complete(unsigned* bar, unsigned x, unsigned& nloc, unsigned& nx) {
    const unsigned G = gridDim.x * gridDim.y * gridDim.z;
    unsigned sum, cnt, mine, sp = 0u;
    for (;;) {
        sum = 0u; cnt = 0u; mine = 0u;
#pragma unroll
        for (unsigned j = 0; j < 16; ++j) { const unsigned c = xb_ld(&bar[XB_XCNT(j)]); sum += c; cnt += (c > 0u) ? 1u : 0u; mine = (j == x) ? c : mine; }
        if (sum == G) break;
        __builtin_amdgcn_s_sleep(1);
        if ((++sp & 255u) == 0u) { if (xb_ld(&bar[XB_TMO])) break; if (sp > XB_SPIN_CAP) { atomicAdd(&bar[XB_TMO], 1u); break; } }
    }
    nloc = mine > 0u ? mine : 1u; nx = cnt > 0u ? cnt : 1u;
}
__device__ __forceinline__ void xcd_barrier(const XcdBarrier& b) {
    asm volatile("s_waitcnt vmcnt(0)" ::: "memory");
    __syncthreads();
    if (threadIdx.x == 0) {
        unsigned* bar = b.bar;
        __builtin_amdgcn_s_waitcnt(0);
        unsigned nloc = b.st[0], nx = b.st[1];
        if (nloc == 0u) { xcd_barrier_complete(bar, b.x, nloc, nx); b.st[0] = nloc; b.st[1] = nx; }
        const unsigned old = xb_add(&bar[XB_XSUB(b.x)], 1u);
        const unsigned gen = old / nloc;
        if (old + 1u == (gen + 1u) * nloc) {
            __builtin_amdgcn_fence(__ATOMIC_RELEASE, "agent");
            asm volatile("s_waitcnt vmcnt(0)" ::: "memory");
            const unsigned og = xb_add(&bar[XB_TOP], 1u);
            const unsigned tg = og / nx;
            if (og + 1u == (tg + 1u) * nx) xb_add(&bar[XB_TOPGEN], 1u);
            else XB_SPIN(xb_ld(&bar[XB_TOPGEN]) == tg, bar);
            __builtin_amdgcn_fence(__ATOMIC_ACQUIRE, "agent");
            xb_add(&bar[XB_XGEN(b.x)], 1u);
            asm volatile("s_waitcnt vmcnt(0)" ::: "memory");
        } else {
            XB_SPIN(xb_ld(&bar[XB_XGEN(b.x)]) == gen, bar);
            __builtin_amdgcn_fence(__ATOMIC_ACQUIRE, "agent");
            asm volatile("s_waitcnt vmcnt(0)" ::: "memory");
        }
    }
    __syncthreads();
}

__global__ void __launch_bounds__(512, 2) fwd_kernel(Params p) {
    extern __shared__ __attribute__((aligned(16))) unsigned char lds_raw[];
    LAS unsigned char* lds = (LAS unsigned char*)lds_raw;
    cg::grid_group grid = cg::this_grid();
    volatile LAS unsigned* xst = (volatile LAS unsigned*)(lds + LDS_MAIN);
    if (threadIdx.x == 0) { xst[0] = 0u; xst[1] = 0u; }
    __syncthreads();
    const XcdBarrier xbar = xcd_barrier_post((unsigned*)(p.ws + WS_BAR), xst);
    if (p.ph_hi > NPHASE + 100) grid.sync();
    bf16_t* W1A = (bf16_t*)(p.ws + WS_W1A); bf16_t* W1B = (bf16_t*)(p.ws + WS_W1B); bf16_t* WIN = (bf16_t*)(p.ws + WS_WIN); bf16_t* WOUT = (bf16_t*)(p.ws + WS_WOUT);
    bf16_t* W2A = (bf16_t*)(p.ws + WS_W2A); bf16_t* W2B = (bf16_t*)(p.ws + WS_W2B);
    bf16_t* HB = (bf16_t*)(p.ws + WS_ABUF); bf16_t* MIXB = (bf16_t*)p.out; float* RS = (float*)(p.ws + WS_RS); bf16_t* ACT = (bf16_t*)(p.ws + WS_ACT); bf16_t* FB = (bf16_t*)(p.ws + WS_F); bf16_t* ZB = (bf16_t*)(p.ws + WS_Z);
    for (int ph = p.ph_lo; ph < p.ph_hi; ++ph) {
      const int nrep = ((REPMASK >> ph) & 1) ? 2 : 1;
      for (int rep = 0; rep < nrep; ++rep) {
        int tid = threadIdx.x, bid = blockIdx.x;
        asm volatile("" : "+v"(tid), "+s"(bid));
        if (ph == 0 && (PHMASK & 1)) {
            prep_weights(p, lds, tid, bid);
            ew_phase<true>(nullptr, 0.f, nullptr, p.in[0], p.in[1], nullptr, nullptr, HB, RS, MROWS, tid, bid);
        } else if ((ph == 1 || ph == 9) && (PHMASK & 2)) {
            pg8::Gemm g{HB, ph == 1 ? W1A : W2A, MX, 2 * DFF, D}; pg8::StaticOrder S; S.init(MX, 2 * DFF, gridDim.x, bid);
            pg8::EpiSwiglu E{ACT, DFF, RS};
            pg8::gemm_phase<pg8::EpiSwiglu>(lds, g, S, E, tid);
            if (ph == 1) skinny16(lds, HB + (size_t)MX * D, D, W1A, DFF / 16, 1, ACT + (size_t)MX * DFF, DFF, RS + MX, tid, bid);
        } else if ((ph == 2 || ph == 4 || ph == 7 || ph == 10) && (PHMASK & 4)) {
            const bf16_t* A; const bf16_t* Bt; bf16_t* O; int N, K; const float* rs = nullptr;
            if (ph == 2)      { A = ACT;  Bt = W1B;  O = FB; N = D;    K = DFF; }
            else if (ph == 4) { A = HB;   Bt = WIN;  O = ZB; N = NINC; K = D; rs = RS; }
            else if (ph == 7) { A = MIXB; Bt = WOUT; O = FB; N = D;    K = D; }
            else              { A = ACT;  Bt = W2B;  O = FB; N = D;    K = DFF; }
            pg8::Gemm g{A, Bt, MX, N, K}; pg8::StaticOrder S; S.init(MX, N, gridDim.x, bid);
            pg8::EpiBf16 E{O, N, rs};
            pg8::gemm_phase<pg8::EpiBf16>(lds, g, S, E, tid);
            if (ph == 2 || ph == 4) skinny16(lds, A + (size_t)MX * K, K, Bt, N / 16, 0, O + (size_t)MX * N, N, rs ? rs + MX : nullptr, tid, bid);
        } else if ((ph == 3 || ph == 8 || ph == 11) && (PHMASK & 8)) {
            const float* gp = ph == 3 ? p.in[6] : (ph == 8 ? p.in[20] : p.in[25]);
            ew_phase<false>(FB, ph == 8 ? 1.0f : 0.5f, gp, nullptr, nullptr, HB, ph == 11 ? p.out : nullptr, ph == 11 ? nullptr : HB, RS, ph == 3 ? MROWS : MX, tid, bid);
        } else if (ph == 5 && (PHMASK & 16)) {
            mixer_lru_scan(p, lds, tid, bid); mixer_sconv(p, tid, bid);
        } else if (ph == 6 && (PHMASK & 32)) {
            mixer_lru_out(p, tid, bid);
        }
        if (ph + 1 < p.ph_hi || rep + 1 < nrep) xcd_barrier(xbar);
      }
    }
}

extern "C" void kernel_launch(void* const* d_in, const int* in_sizes, int n_in, void* d_out, int out_size, void* d_ws, size_t ws_size, hipStream_t stream) {
    static int grid = 0;
    if (grid == 0) {
        if (n_in != 26 || out_size != MX * D || ws_size < WS_END) { fprintf(stderr, "kernel_launch: unexpected shapes (n_in %d out %d ws %zu need %zu)\n", n_in, out_size, ws_size, (size_t)WS_END); grid = -1; return; }
        int dev = 0, cus = 0, per_cu = 0;
        hipGetDevice(&dev); hipDeviceGetAttribute(&cus, hipDeviceAttributeMultiprocessorCount, dev);
        if (hipFuncSetAttribute((const void*)fwd_kernel, hipFuncAttributeMaxDynamicSharedMemorySize, LDS_BYTES) != hipSuccess) { fprintf(stderr, "kernel_launch: hipFuncSetAttribute failed\n"); grid = -1; return; }
        if (hipOccupancyMaxActiveBlocksPerMultiprocessor(&per_cu, (const void*)fwd_kernel, 512, LDS_BYTES) != hipSuccess || per_cu < 1) { fprintf(stderr, "kernel_launch: occupancy query gave %d\n", per_cu); per_cu = 1; }
        (void)hipGetLastError();
        grid = cus * 1;
        fprintf(stderr, "kernel_launch: grid %d (cus %d, per_cu %d)\n", grid, cus, per_cu);
    }
    if (grid < 0) return;
    if (hipMemsetAsync((char*)d_ws + WS_BAR, 0, XCD_BAR_WORDS * 4, stream) != hipSuccess) { fprintf(stderr, "kernel_launch: memset of the barrier words failed\n"); return; }
    Params p{};
    for (int i = 0; i < 26; ++i) p.in[i] = (const float*)d_in[i];
    p.out = (float*)d_out; p.ws = (unsigned char*)d_ws;
#if ONE_LAUNCH
    p.ph_lo = 0; p.ph_hi = NPHASE;
    { void* args[] = {&p}; hipError_t e = hipLaunchCooperativeKernel((const void*)fwd_kernel, dim3(grid), dim3(512), args, LDS_BYTES, stream);
      if (e != hipSuccess) fprintf(stderr, "cooperative launch failed: %s\n", hipGetErrorString(e)); }
#else
    for (int ph = 0; ph < NPHASE; ++ph) {
        p.ph_lo = ph; p.ph_hi = ph + 1;
        void* args[] = {&p}; hipError_t e = hipLaunchCooperativeKernel((const void*)fwd_kernel, dim3(grid), dim3(512), args, LDS_BYTES, stream);
        if (e != hipSuccess) { fprintf(stderr, "cooperative launch %d failed: %s\n", ph, hipGetErrorString(e)); break; }
    }
#endif
}
```

```cpp
#include <hip/hip_runtime.h>
#include <hip/hip_cooperative_groups.h>
#include <cstdio>
namespace cg = cooperative_groups;

#ifndef PHMASK
#define PHMASK 0xFFF
#endif
#ifndef REPMASK
#define REPMASK 0
#endif
#ifndef ONE_LAUNCH
#define ONE_LAUNCH 1
#endif

#define LAS __attribute__((address_space(3)))
typedef unsigned short bf16_t;
typedef short bf16x8 __attribute__((ext_vector_type(8)));
typedef float f32x4 __attribute__((ext_vector_type(4)));
typedef unsigned u32x4 __attribute__((ext_vector_type(4)));
typedef unsigned u32x2 __attribute__((ext_vector_type(2)));

constexpr int D = 2048, DFF = 5504, DL = 1024, NINC = 5120, SEQ = 4096, NBATCH = 4, NMETA = 16;
constexpr int MX = NBATCH * SEQ;
constexpr int MROWS = MX + NMETA;
constexpr int NTILE = 65;
constexpr float EPS = 1e-6f;
constexpr int NPHASE = 12;
constexpr int LDS_MAIN = 131072, LDS_RS_OFF = LDS_MAIN + 64, LDS_RS_UNITS = 24, LDS_BYTES = LDS_RS_OFF + LDS_RS_UNITS * 1024;

constexpr size_t SZ_WA = (size_t)2 * DFF * D * 2, SZ_WB = (size_t)D * DFF * 2, SZ_WIN = (size_t)NINC * D * 2, SZ_WOUT = (size_t)D * D * 2;
constexpr size_t WS_W1A = 0, WS_W1B = WS_W1A + SZ_WA, WS_WIN = WS_W1B + SZ_WB, WS_WOUT = WS_WIN + SZ_WIN, WS_W2A = WS_WOUT + SZ_WOUT, WS_W2B = WS_W2A + SZ_WA;
constexpr size_t WS_ABUF = WS_W2B + SZ_WB;
constexpr size_t WS_ACT = WS_ABUF + (size_t)MROWS * D * 2;
constexpr size_t WS_F = WS_ACT + (size_t)MROWS * DFF * 2;
constexpr size_t WS_Z = WS_ACT;
constexpr size_t WS_SUMA = WS_F + (size_t)MROWS * D * 2;
constexpr size_t WS_SUMH = WS_SUMA + (size_t)NBATCH * NTILE * DL * 4;
constexpr size_t WS_BAR = WS_SUMH + (size_t)NBATCH * NTILE * DL * 4;
constexpr size_t WS_RS = WS_BAR + 16384;
constexpr size_t WS_END = WS_RS + 65792;
static_assert((size_t)MROWS * NINC * 2 <= (size_t)MROWS * DFF * 2 + (size_t)MROWS * D * 2, "Z must fit in ACT+F");

struct Params { const float* in[26]; float* out; unsigned char* ws; int ph_lo, ph_hi; };

__device__ __forceinline__ unsigned cvt_pk_bf16(float lo, float hi) { unsigned r; asm volatile("v_cvt_pk_bf16_f32 %0, %1, %2" : "=v"(r) : "v"(lo), "v"(hi)); return r; }
__device__ __forceinline__ bf16_t f2bf(float x) { return (bf16_t)(cvt_pk_bf16(x, 0.f) & 0xffffu); }
__device__ __forceinline__ float bf2f(bf16_t h) { return __uint_as_float(((unsigned)h) << 16); }
__device__ __forceinline__ float bflo(unsigned w) { return __uint_as_float(w << 16); }
__device__ __forceinline__ float bfhi(unsigned w) { return __uint_as_float(w & 0xffff0000u); }
__device__ __forceinline__ float wave_sum(float v) {
#pragma unroll
    for (int o = 32; o >= 1; o >>= 1) v += __shfl_xor(v, o);
    return v;
}
template <int CTRL> __device__ __forceinline__ float dpp_f(float v) { return __builtin_bit_cast(float, __builtin_amdgcn_update_dpp(0, __builtin_bit_cast(int, v), CTRL, 0xf, 0xf, true)); }
__device__ __forceinline__ float row16_sum(float v) {
    v += dpp_f<0xB1>(v); v += dpp_f<0x4E>(v); v += dpp_f<0x141>(v); v += dpp_f<0x140>(v); return v;
}
__device__ __forceinline__ float wave64_sum(float v) {
    const float r = row16_sum(v); const int ri = __builtin_bit_cast(int, r);
    return __builtin_bit_cast(float, __builtin_amdgcn_readlane(ri, 0)) + __builtin_bit_cast(float, __builtin_amdgcn_readlane(ri, 16)) + __builtin_bit_cast(float, __builtin_amdgcn_readlane(ri, 32)) + __builtin_bit_cast(float, __builtin_amdgcn_readlane(ri, 48));
}
__device__ __forceinline__ float silu_f(float g) { return g * __builtin_amdgcn_rcpf(1.0f + __expf(-g)); }
__device__ __forceinline__ float sigmoid_f(float g) { return 1.0f / (1.0f + __expf(-g)); }
__device__ __forceinline__ float gelu_tanh_f(float y) { const float t = tanhf(0.7978845608028654f * (y + 0.044715f * y * y * y)); return 0.5f * y * (1.0f + t); }
__device__ __forceinline__ int zrow(int b, int s) { return s < NMETA ? MX + s : b * SEQ + (s - NMETA); }

namespace pg8 {
constexpr int BM = 256, BK = 64, HALF = 128, HTB = HALF * BK * 2, STAGE_BYTES = 8 * HTB, NXCD = 8;
__device__ __forceinline__ int lds_byte(int r, int c) { const int st = (r >> 4) * 2 + (c >> 5), rr = r & 15, cc = c & 31, ob = rr * 64 + cc * 2; return st * 1024 + (ob ^ (((ob >> 9) & 1) << 5)); }
__device__ __forceinline__ void stage_rc(int b, int& R, int& C) { const int st = b / 1024, sb = b % 1024, swz = sb ^ (((sb >> 9) & 1) << 5); R = (st >> 1) * 16 + swz / 64; C = (st & 1) * 32 + (swz % 64) / 2; }
__device__ __forceinline__ int perm32(int rho) { const int n = rho >> 4, i = rho & 15; return 8 * (i >> 2) + 4 * n + (i & 3); }
struct Unit { int pm, pn; };
struct Gemm { const bf16_t* A; const bf16_t* Bt; int M, N, K; };
struct StaticOrder {
    int nM, nN, nwg, G, c, WGM;
    __device__ void init(int M, int N, int G_, int c_) { nM = M / BM; nN = N / BM; nwg = nM * nN; G = G_; c = c_; WGM = nN == 8 ? 4 : 8; }
    __device__ bool next(int i, Unit& u) const {
        const long L = (long)i * G + c; if (L >= nwg) return false;
        int wgid = (int)L; { const int q = nwg / NXCD, r = nwg % NXCD, xcd = wgid % NXCD, off = wgid / NXCD; wgid = (xcd < r ? xcd * (q + 1) : r * (q + 1) + (xcd - r) * q) + off; }
        const int nig = WGM * nN, gid = wgid / nig, fm = gid * WGM, gsz = (nM - fm) < WGM ? (nM - fm) : WGM;
        u.pm = fm + ((wgid % nig) % gsz); u.pn = (wgid % nig) / gsz; return true;
    }
};
struct EpiBf16 {
    static constexpr bool PERM = true;
    bf16_t* O; int ldc; const float* rs;
    __device__ __forceinline__ void operator()(const f32x4 (&acc)[2][2][4][2], const Unit& u, int wr, int wc, int fr, int fq, const LAS float* rsl) const {
        const int row0 = u.pm * BM + wr * 64 + fr, col0 = u.pn * BM + wc * 32 + 8 * fq;
#pragma unroll
        for (int ai = 0; ai < 2; ++ai)
#pragma unroll
            for (int m = 0; m < 4; ++m) { bf16_t* rowp = O + (size_t)(row0 + ai * HALF + m * 16) * ldc + col0; const float sc = rs ? rsl[wr * 64 + fr + ai * HALF + m * 16] : 1.0f;
#pragma unroll
                for (int bj = 0; bj < 2; ++bj) { const f32x4 v0 = acc[ai][bj][m][0] * sc, v1 = acc[ai][bj][m][1] * sc;
                    u32x4 w; w.x = cvt_pk_bf16(v0[0], v0[1]); w.y = cvt_pk_bf16(v0[2], v0[3]); w.z = cvt_pk_bf16(v1[0], v1[1]); w.w = cvt_pk_bf16(v1[2], v1[3]);
                    *(u32x4*)(rowp + bj * HALF) = w; } }
    }
};
struct EpiSwiglu {
    static constexpr bool PERM = true;
    bf16_t* O; int ldc; const float* rs;
    __device__ __forceinline__ void operator()(const f32x4 (&acc)[2][2][4][2], const Unit& u, int wr, int wc, int fr, int fq, const LAS float* rsl) const {
        const int row0 = u.pm * BM + wr * 64 + fr, col0 = u.pn * HALF + wc * 32 + 8 * fq;
#pragma unroll
        for (int ai = 0; ai < 2; ++ai)
#pragma unroll
            for (int m = 0; m < 4; ++m) { bf16_t* rowp = O + (size_t)(row0 + ai * HALF + m * 16) * ldc + col0;
                const float sc = rsl[wr * 64 + fr + ai * HALF + m * 16], k1 = -1.4426950408889634f * sc, sc2 = sc * sc;
                const f32x4 g0 = acc[ai][0][m][0], g1 = acc[ai][0][m][1], u0 = acc[ai][1][m][0], u1 = acc[ai][1][m][1];
                float v[8];
#pragma unroll
                for (int j = 0; j < 4; ++j) { v[j] = (g0[j] * u0[j]) * (sc2 * __builtin_amdgcn_rcpf(1.0f + __builtin_amdgcn_exp2f(g0[j] * k1)));
                                              v[4 + j] = (g1[j] * u1[j]) * (sc2 * __builtin_amdgcn_rcpf(1.0f + __builtin_amdgcn_exp2f(g1[j] * k1))); }
                u32x4 w; w.x = cvt_pk_bf16(v[0], v[1]); w.y = cvt_pk_bf16(v[2], v[3]); w.z = cvt_pk_bf16(v[4], v[5]); w.w = cvt_pk_bf16(v[6], v[7]);
                *(u32x4*)rowp = w; }
    }
};

template <class Epi>
__device__ __forceinline__ void gemm_phase(LAS unsigned char* lds, const Gemm g, const StaticOrder& S, const Epi& E, const int tid) {
    const int wid = __builtin_amdgcn_readfirstlane(tid >> 6), lane = tid & 63, wr = wid >> 2, wc = wid & 3, fr = lane & 15, fq = lane >> 4;
    const int K = g.K, nt = K / BK;
    unsigned voffA[2], voffB[2];
#pragma unroll
    for (int i = 0; i < 2; ++i) { int R, C; stage_rc(tid * 16 + i * 8192, R, C); const int Rb = Epi::PERM ? ((R & ~31) + perm32(R & 31)) : R;
        voffA[i] = (unsigned)(R * K + C) * 2u; voffB[i] = (unsigned)(Rb * K + C) * 2u; }
    const size_t kstep = (size_t)(BK * 2);
    const size_t hstep = (size_t)HALF * K * 2;
    const size_t tstep = 2 * hstep;
    const unsigned ldsw = (unsigned)wid * 1024u;
    const int aoff = lds_byte(wr * 64 + fr, fq * 8), boff = lds_byte(wc * 32 + fr, fq * 8);
#define PG8_SA(b, h) (((b) * 2 + (h)) * HTB)
#define PG8_SB(b, h) ((4 + (b) * 2 + (h)) * HTB)
#define PG8_STAGE(bufoff, gbase, voff) do { _Pragma("unroll") for (int _i = 0; _i < 2; ++_i) \
        __builtin_amdgcn_global_load_lds((const unsigned*)((const char*)(gbase) + (voff)[_i]), (LAS unsigned*)(lds + (bufoff) + ldsw + _i * 8192), 16, 0, 0); } while (0)
#define PG8_LDA(dst, b, h) do { _Pragma("unroll") for (int m = 0; m < 4; ++m) _Pragma("unroll") for (int k = 0; k < 2; ++k) dst[m][k] = *(const LAS bf16x8*)(lds + PG8_SA(b, h) + aoff + m * 2048 + k * 1024); } while (0)
#define PG8_LDB(dst, b, h) do { _Pragma("unroll") for (int n = 0; n < 2; ++n) _Pragma("unroll") for (int k = 0; k < 2; ++k) dst[n][k] = *(const LAS bf16x8*)(lds + PG8_SB(b, h) + boff + n * 2048 + k * 1024); } while (0)
#define PG8_MMA(ai, bj, At, Bt) do { __builtin_amdgcn_s_setprio(1); _Pragma("unroll") for (int m = 0; m < 4; ++m) _Pragma("unroll") for (int n = 0; n < 2; ++n) _Pragma("unroll") for (int k = 0; k < 2; ++k) \
        acc[ai][bj][m][n] = __builtin_amdgcn_mfma_f32_16x16x32_bf16(Bt[n][k], At[m][k], acc[ai][bj][m][n], 0, 0, 0); __builtin_amdgcn_s_setprio(0); } while (0)
#define PG8_WAIT_V(n) asm volatile("s_waitcnt vmcnt(" #n ")" ::: "memory")
#define PG8_WAIT_L(n) asm volatile("s_waitcnt lgkmcnt(" #n ")" ::: "memory")
#define PG8_BAR __builtin_amdgcn_s_barrier()
#define PG8_SCHED __builtin_amdgcn_sched_barrier(0)
    Unit cur, nxt; int ui = 0;
    LAS float* rsl = (LAS float*)(lds + LDS_RS_OFF);
    if (E.rs) { Unit uu; for (int i = 0; i < LDS_RS_UNITS && S.next(i, uu); ++i) if (tid < 256) rsl[i * 256 + tid] = E.rs[uu.pm * BM + tid]; }
    __syncthreads();
    if (!S.next(0, cur)) return;
    f32x4 acc[2][2][4][2];
#pragma unroll
    for (int a = 0; a < 2; ++a)
#pragma unroll
        for (int b = 0; b < 2; ++b)
#pragma unroll
            for (int m = 0; m < 4; ++m)
#pragma unroll
                for (int n = 0; n < 2; ++n) acc[a][b][m][n] = (f32x4){0.f, 0.f, 0.f, 0.f};
    bf16x8 At[4][2], B0[2][2], B1[2][2];
    const char* cA = (const char*)g.A + (size_t)cur.pm * tstep; const char* cB = (const char*)g.Bt + (size_t)cur.pn * tstep;
    PG8_STAGE(PG8_SB(0, 0), cB, voffB); PG8_STAGE(PG8_SA(0, 0), cA, voffA); PG8_STAGE(PG8_SB(0, 1), cB + hstep, voffB); PG8_STAGE(PG8_SA(0, 1), cA + hstep, voffA);
    if (wr == 1) PG8_BAR;
    PG8_WAIT_V(4); PG8_BAR;
    PG8_STAGE(PG8_SB(1, 0), cB + kstep, voffB); PG8_STAGE(PG8_SA(1, 0), cA + kstep, voffA); PG8_STAGE(PG8_SB(1, 1), cB + hstep + kstep, voffB);
    PG8_WAIT_V(6); PG8_BAR;
    for (;;) {
        const bool has_next = S.next(ui + 1, nxt);
        const char* nA = has_next ? (const char*)g.A + (size_t)nxt.pm * tstep : cA; const char* nB = has_next ? (const char*)g.Bt + (size_t)nxt.pn * tstep : cB;
        for (int t = 0; t < nt; t += 2) {
            const bool last = (t == nt - 2);
            const char* a1 = cA + (size_t)(t + 1) * kstep;
            const char* a2 = last ? nA : cA + (size_t)(t + 2) * kstep; const char* b2 = last ? nB : cB + (size_t)(t + 2) * kstep;
            const char* a3 = a2 + kstep; const char* b3 = b2 + kstep;
            PG8_LDB(B0, 0, 0); PG8_SCHED; PG8_LDA(At, 0, 0); PG8_STAGE(PG8_SA(1, 1), a1 + hstep, voffA);
            PG8_WAIT_L(8); PG8_BAR; PG8_WAIT_L(0); PG8_MMA(0, 0, At, B0); PG8_BAR; PG8_SCHED;
            PG8_LDB(B1, 0, 1); PG8_STAGE(PG8_SB(0, 0), b2, voffB);
            PG8_BAR; PG8_WAIT_L(0); PG8_MMA(0, 1, At, B1); PG8_BAR;
            PG8_LDA(At, 0, 1); PG8_STAGE(PG8_SA(0, 0), a2, voffA);
            PG8_BAR; PG8_WAIT_L(0); PG8_MMA(1, 0, At, B0); PG8_BAR; PG8_SCHED;
            PG8_STAGE(PG8_SB(0, 1), b2 + hstep, voffB);
            PG8_WAIT_V(6); PG8_BAR; PG8_MMA(1, 1, At, B1); PG8_BAR;
            PG8_LDB(B0, 1, 0); PG8_SCHED; PG8_LDA(At, 1, 0); PG8_STAGE(PG8_SA(0, 1), a2 + hstep, voffA);
            PG8_WAIT_L(8); PG8_BAR; PG8_WAIT_L(0); PG8_MMA(0, 0, At, B0); PG8_BAR; PG8_SCHED;
            PG8_LDB(B1, 1, 1); PG8_STAGE(PG8_SB(1, 0), b3, voffB);
            PG8_BAR; PG8_WAIT_L(0); PG8_MMA(0, 1, At, B1); PG8_BAR;
            PG8_LDA(At, 1, 1); PG8_STAGE(PG8_SA(1, 0), a3, voffA);
            PG8_BAR; PG8_WAIT_L(0); PG8_MMA(1, 0, At, B0); PG8_BAR; PG8_SCHED;
            PG8_STAGE(PG8_SB(1, 1), b3 + hstep, voffB);
            PG8_WAIT_V(6); PG8_BAR; PG8_MMA(1, 1, At, B1); PG8_BAR;
        }
        E(acc, cur, wr, wc, fr, fq, rsl + ui * 256);
        if (!has_next) break;
#pragma unroll
        for (int a = 0; a < 2; ++a)
#pragma unroll
            for (int b = 0; b < 2; ++b)
#pragma unroll
                for (int m = 0; m < 4; ++m)
#pragma unroll
                    for (int n = 0; n < 2; ++n) acc[a][b][m][n] = (f32x4){0.f, 0.f, 0.f, 0.f};
        cur = nxt; cA = nA; cB = nB; ++ui;
    }
    PG8_WAIT_V(0);
    if (wr == 0) PG8_BAR;
    PG8_BAR;
#undef PG8_SA
#undef PG8_SB
#undef PG8_STAGE
#undef PG8_LDA
#undef PG8_LDB
#undef PG8_MMA
#undef PG8_WAIT_V
#undef PG8_WAIT_L
#undef PG8_BAR
#undef PG8_SCHED
}
}

__device__ __forceinline__ void skinny16(LAS unsigned char* lds, const bf16_t* A, int K, const bf16_t* Bt, int ntiles, int mode, bf16_t* O, int ldo, const float* rs, const int tid, const int bid) {
    const int wid = __builtin_amdgcn_readfirstlane(tid >> 6), lane = tid & 63, fr = lane & 15, fq = lane >> 4;
    LAS f32x4* RED = (LAS f32x4*)lds;
    const int nsteps = K / 32;
    for (int tile = (int)gridDim.x - 1 - bid; tile < ntiles; tile += gridDim.x) {
        const int c0 = 16 * tile, rb0 = mode ? ((c0 >> 7) * 256 + (c0 & 127)) : c0;
        f32x4 acc0 = (f32x4){0.f, 0.f, 0.f, 0.f}, acc1 = (f32x4){0.f, 0.f, 0.f, 0.f};
        const bf16_t* ap = A + (size_t)fr * K + fq * 8;
        const bf16_t* bp0 = Bt + (size_t)(rb0 + fr) * K + fq * 8;
        const bf16_t* bp1 = bp0 + (size_t)128 * K;
        for (int s = wid; s < nsteps; s += 32) {
            bf16x8 a[4], b0[4], b1[4];
#pragma unroll
            for (int j = 0; j < 4; ++j) { const int sj = s + 8 * j, sc = sj < nsteps ? sj : s;
                a[j] = *(const bf16x8*)(ap + sc * 32); b0[j] = *(const bf16x8*)(bp0 + sc * 32); if (mode) b1[j] = *(const bf16x8*)(bp1 + sc * 32); }
#pragma unroll
            for (int j = 0; j < 4; ++j) if (s + 8 * j < nsteps) {
                acc0 = __builtin_amdgcn_mfma_f32_16x16x32_bf16(b0[j], a[j], acc0, 0, 0, 0);
                if (mode) acc1 = __builtin_amdgcn_mfma_f32_16x16x32_bf16(b1[j], a[j], acc1, 0, 0, 0); }
        }
        RED[(wid * 2 + 0) * 64 + lane] = acc0; RED[(wid * 2 + 1) * 64 + lane] = acc1;
        __syncthreads();
        if (wid == 0) {
            f32x4 s0 = (f32x4){0.f, 0.f, 0.f, 0.f}, s1 = s0;
#pragma unroll
            for (int w = 0; w < 8; ++w) { s0 += RED[(w * 2 + 0) * 64 + lane]; s1 += RED[(w * 2 + 1) * 64 + lane]; }
            if (rs) { const float sc = rs[fr]; s0 *= sc; s1 *= sc; }
            if (mode) {
#pragma unroll
                for (int j = 0; j < 4; ++j) s0[j] = silu_f(s0[j]) * s1[j];
            }
            u32x2 w; w.x = cvt_pk_bf16(s0[0], s0[1]); w.y = cvt_pk_bf16(s0[2], s0[3]);
            *(u32x2*)(O + (size_t)fr * ldo + c0 + 4 * fq) = w;
        }
        __syncthreads();
    }
}

struct TileDesc { const float* src; bf16_t* dst; const float* g; int N, K; };
__device__ __forceinline__ TileDesc decode_tile(const Params& p, int g) {
    const float* W; bf16_t* out; const float* gn = nullptr; int K, N, mode, loc;
    if (g < 688)       { W = p.in[3];  out = (bf16_t*)(p.ws + WS_W1A); K = D;   N = DFF;  mode = 1; loc = g; gn = p.in[2]; }
    else if (g < 1376) { W = p.in[4];  out = (bf16_t*)(p.ws + WS_W1A); K = D;   N = DFF;  mode = 2; loc = g - 688; gn = p.in[2]; }
    else if (g < 2064) { W = p.in[5];  out = (bf16_t*)(p.ws + WS_W1B); K = DFF; N = D;    mode = 0; loc = g - 1376; }
    else if (g < 2704) { W = p.in[8];  out = (bf16_t*)(p.ws + WS_WIN); K = D;   N = NINC; mode = 0; loc = g - 2064; gn = p.in[7]; }
    else if (g < 2960) { W = p.in[19]; out = (bf16_t*)(p.ws + WS_WOUT); K = D;  N = D;    mode = 0; loc = g - 2704; }
    else if (g < 3648) { W = p.in[22]; out = (bf16_t*)(p.ws + WS_W2A); K = D;   N = DFF;  mode = 1; loc = g - 2960; gn = p.in[21]; }
    else if (g < 4336) { W = p.in[23]; out = (bf16_t*)(p.ws + WS_W2A); K = D;   N = DFF;  mode = 2; loc = g - 3648; gn = p.in[21]; }
    else               { W = p.in[24]; out = (bf16_t*)(p.ws + WS_W2B); K = DFF; N = D;    mode = 0; loc = g - 4336; }
    const int nNt = N / 128, kt = loc / nNt, ntl = loc % nNt;
    const int rowbase = mode == 0 ? ntl * 128 : ntl * 256 + (mode == 2 ? 128 : 0);
    TileDesc t; t.src = W + (size_t)(kt * 128) * N + ntl * 128; t.dst = out + (size_t)rowbase * K + kt * 128; t.g = gn ? gn + kt * 128 : nullptr; t.N = N; t.K = K; return t;
}
constexpr int PREP_TILES = 5024;
__device__ __forceinline__ void prep_weights(const Params& p, LAS unsigned char* lds, const int tid, const int bid) {
    LAS float* T = (LAS float*)lds;
    const int r = tid >> 5, c4 = tid & 31;
    int g = bid;
    if (g >= PREP_TILES) return;
    TileDesc td = decode_tile(p, g);
    f32x4 v[8];
#pragma unroll
    for (int i = 0; i < 8; ++i) v[i] = *(const f32x4*)(td.src + (size_t)(r + 16 * i) * td.N + 4 * c4);
    for (;;) {
#pragma unroll
        for (int i = 0; i < 8; ++i) { const int k = r + 16 * i; *(LAS f32x4*)(T + k * 132 + 4 * (c4 ^ ((k >> 3) & 7))) = v[i]; }
        __syncthreads();
        const int gn = g + gridDim.x; const bool has_next = gn < PREP_TILES;
        TileDesc tn = td;
        if (has_next) { tn = decode_tile(p, gn);
#pragma unroll
            for (int i = 0; i < 8; ++i) v[i] = *(const f32x4*)(tn.src + (size_t)(r + 16 * i) * tn.N + 4 * c4); }
#pragma unroll
        for (int p2 = 0; p2 < 4; ++p2) { const int cch = tid & 15, nn = (tid >> 4) + 32 * p2, k8 = 8 * cch, ncol = nn ^ (4 * (cch & 7)); float x[8];
#pragma unroll
            for (int i = 0; i < 8; ++i) x[i] = T[(k8 + i) * 132 + ncol];
            if (td.g) { const f32x4 g0 = *(const f32x4*)(td.g + k8), g1 = *(const f32x4*)(td.g + k8 + 4);
                x[0] *= g0[0]; x[1] *= g0[1]; x[2] *= g0[2]; x[3] *= g0[3]; x[4] *= g1[0]; x[5] *= g1[1]; x[6] *= g1[2]; x[7] *= g1[3]; }
            u32x4 w; w.x = cvt_pk_bf16(x[0], x[1]); w.y = cvt_pk_bf16(x[2], x[3]); w.z = cvt_pk_bf16(x[4], x[5]); w.w = cvt_pk_bf16(x[6], x[7]);
            *(u32x4*)(td.dst + (size_t)nn * td.K + k8) = w; }
        __syncthreads();
        if (!has_next) break;
        g = gn; td = tn;
    }
}

template <bool HX> struct EwRows { f32x4 hf[HX ? 2 : 1][HX ? 8 : 1]; u32x2 hw[HX ? 1 : 2][HX ? 1 : 8]; u32x2 fw[HX ? 1 : 2][HX ? 1 : 8]; int rr[2]; };
template <bool HX> __device__ __forceinline__ void ew_load(EwRows<HX>& R, int r0, int nw, int nrows, const bf16_t* F, const float* hx, const float* meta, const bf16_t* hb, int lane) {
    R.rr[0] = r0; R.rr[1] = (r0 + nw < nrows) ? r0 + nw : r0;
#pragma unroll
    for (int q = 0; q < 2; ++q) { const int r = R.rr[q];
        if constexpr (HX) { const float* hp = r < MX ? hx + (size_t)r * D : meta + (size_t)(r - MX) * D;
#pragma unroll
            for (int i = 0; i < 8; ++i) R.hf[q][i] = *(const f32x4*)(hp + i * 256 + lane * 4); }
        else {
#pragma unroll
            for (int i = 0; i < 8; ++i) R.hw[q][i] = *(const u32x2*)(hb + (size_t)r * D + i * 256 + lane * 4);
#pragma unroll
            for (int i = 0; i < 8; ++i) R.fw[q][i] = *(const u32x2*)(F + (size_t)r * D + i * 256 + lane * 4); } }
}
template <bool HX> __device__ __forceinline__ void ew_phase(const bf16_t* F, float coef, const float* gpost, const float* hx, const float* meta, const bf16_t* hb, float* out32, bf16_t* hbo, float* rso, int nrows, const int tid, const int bid) {
    const int lane = tid & 63, gw = bid * 8 + (tid >> 6), nw = gridDim.x * 8;
    if (gw >= nrows) return;
    EwRows<HX> R; ew_load<HX>(R, gw, nw, nrows, F, hx, meta, hb, lane);
    for (int r0 = gw; r0 < nrows; r0 += 2 * nw) {
        EwRows<HX> Nx; const bool has_next = r0 + 2 * nw < nrows;
        if (has_next) ew_load<HX>(Nx, r0 + 2 * nw, nw, nrows, F, hx, meta, hb, lane);
#pragma unroll
        for (int q = 0; q < 2; ++q) { const int r = R.rr[q];
            f32x4 h[8];
#pragma unroll
            for (int i = 0; i < 8; ++i) { if constexpr (HX) h[i] = R.hf[q][i]; else { const u32x2 w = R.hw[q][i]; h[i] = (f32x4){bflo(w.x), bfhi(w.x), bflo(w.y), bfhi(w.y)}; } }
            if constexpr (!HX) {
                f32x4 f[8]; float ss = 0.f;
#pragma unroll
                for (int i = 0; i < 8; ++i) { const u32x2 w = R.fw[q][i]; f[i] = (f32x4){bflo(w.x), bfhi(w.x), bflo(w.y), bfhi(w.y)}; ss += (f[i][0] * f[i][0] + f[i][1] * f[i][1]) + (f[i][2] * f[i][2] + f[i][3] * f[i][3]); }
                ss = wave64_sum(ss);
                const float rs = coef * rsqrtf(ss * (1.0f / D) + EPS);
#pragma unroll
                for (int i = 0; i < 8; ++i) { const f32x4 g = *(const f32x4*)(gpost + i * 256 + lane * 4); h[i] += f[i] * rs * g; }
            }
            if (out32 && r < MX) {
#pragma unroll
                for (int i = 0; i < 8; ++i) *(f32x4*)(out32 + (size_t)r * D + i * 256 + lane * 4) = h[i];
            }
            if (hbo) {
                float ss = 0.f;
#pragma unroll
                for (int i = 0; i < 8; ++i) ss += (h[i][0] * h[i][0] + h[i][1] * h[i][1]) + (h[i][2] * h[i][2] + h[i][3] * h[i][3]);
                ss = wave64_sum(ss);
                if (lane == 0) rso[r] = rsqrtf(ss * (1.0f / D) + EPS);
#pragma unroll
                for (int i = 0; i < 8; ++i) { u32x2 w; w.x = cvt_pk_bf16(h[i][0], h[i][1]); w.y = cvt_pk_bf16(h[i][2], h[i][3]);
                    *(u32x2*)(hbo + (size_t)r * D + i * 256 + lane * 4) = w; }
            }
        }
        if (has_next) R = Nx;
    }
}

constexpr int L_XIN = 0, L_XC = 17152, L_AA = L_XC + 16640, L_UU = L_AA + 16640, L_XCB = L_UU + 16640, L_WA = L_XCB + 9216, L_WX = L_WA + 9216, L_PART = L_WX + 9216, L_END = L_PART + 4096;
static_assert(L_END <= LDS_MAIN, "mixer LDS");
constexpr int NRUN = 16;
struct HeadConst { float cw0, cw1, cw2, cw3, cb, go; float sp[8], ba[8], bx[8]; };
__device__ __forceinline__ void lru_load_head(const Params& p, LAS unsigned char* lds, int h, const int tid, HeadConst& hc) {
    LAS bf16_t* WA = (LAS bf16_t*)(lds + L_WA); LAS bf16_t* WX = (LAS bf16_t*)(lds + L_WX);
    const float* wa = p.in[11] + (size_t)h * 4096; const float* wx = p.in[13] + (size_t)h * 4096;
    for (int e = tid; e < 4096; e += 512) { const int i = e >> 6, j = e & 63; WA[j * 72 + i] = f2bf(wa[e]); WX[j * 72 + i] = f2bf(wx[e]); }
    const int lane = tid & 63, wid = tid >> 6, fq = lane >> 4, nh = wid >> 2, ch = 64 * h + lane;
    hc.cw0 = p.in[9][ch]; hc.cw1 = p.in[9][DL + ch]; hc.cw2 = p.in[9][2 * DL + ch]; hc.cw3 = p.in[9][3 * DL + ch]; hc.cb = p.in[10][ch]; hc.go = p.in[17][ch];
#pragma unroll
    for (int k = 0; k < 8; ++k) { const int c2 = 64 * h + 16 * (2 * nh + (k >> 2)) + 4 * fq + (k & 3);
        hc.sp[k] = -8.0f * log1pf(__expf(-p.in[15][c2])); hc.ba[k] = p.in[12][c2]; hc.bx[k] = p.in[14][c2]; }
}
struct XinRegs { u32x4 a, b; };
__device__ __forceinline__ void xin_prefetch(const bf16_t* Z, int b, int h, int v, const int tid, XinRegs& x) {
    const int s0 = v < 0 ? 0 : NMETA + 64 * v, ntok = v < 0 ? NMETA : 64;
    x.a = (u32x4){0u, 0u, 0u, 0u}; x.b = x.a;
    { const int row = tid >> 3, seg = tid & 7, s = s0 - 3 + row; if (s >= 0 && row < ntok + 3) x.a = *(const u32x4*)(Z + (size_t)zrow(b, s) * NINC + DL + 64 * h + 8 * seg); }
    if (tid < 24) { const int e = 512 + tid, row = e >> 3, seg = e & 7, s = s0 - 3 + row; if (s >= 0 && row < ntok + 3) x.b = *(const u32x4*)(Z + (size_t)zrow(b, s) * NINC + DL + 64 * h + 8 * seg); }
}
__device__ __forceinline__ void xin_store(LAS float* XIN, const int tid, const XinRegs& x) {
    { LAS float* d = XIN + tid * 8; *(LAS f32x4*)d = (f32x4){bflo(x.a.x), bfhi(x.a.x), bflo(x.a.y), bfhi(x.a.y)}; *(LAS f32x4*)(d + 4) = (f32x4){bflo(x.a.z), bfhi(x.a.z), bflo(x.a.w), bfhi(x.a.w)}; }
    if (tid < 24) { LAS float* d = XIN + (512 + tid) * 8; *(LAS f32x4*)d = (f32x4){bflo(x.b.x), bfhi(x.b.x), bflo(x.b.y), bfhi(x.b.y)}; *(LAS f32x4*)(d + 4) = (f32x4){bflo(x.b.z), bfhi(x.b.z), bflo(x.b.w), bfhi(x.b.w)}; }
}
__device__ __forceinline__ void lru_tile_math(LAS unsigned char* lds, const int tid, const HeadConst& hc) {
    const int wid = __builtin_amdgcn_readfirstlane(tid >> 6), lane = tid & 63, fr = lane & 15, fq = lane >> 4;
    LAS float* XIN = (LAS float*)(lds + L_XIN); LAS float* XC = (LAS float*)(lds + L_XC); LAS float* AA = (LAS float*)(lds + L_AA); LAS float* UU = (LAS float*)(lds + L_UU);
    LAS bf16_t* XCB = (LAS bf16_t*)(lds + L_XCB); LAS bf16_t* WA = (LAS bf16_t*)(lds + L_WA); LAS bf16_t* WX = (LAS bf16_t*)(lds + L_WX);
    { const int c = lane;
#pragma unroll
      for (int q = 0; q < 8; ++q) { const int t = wid + 8 * q;
          const float xc = hc.cb + hc.cw0 * XIN[t * 64 + c] + hc.cw1 * XIN[(t + 1) * 64 + c] + hc.cw2 * XIN[(t + 2) * 64 + c] + hc.cw3 * XIN[(t + 3) * 64 + c];
          XC[t * 65 + c] = xc; XCB[t * 72 + c] = f2bf(xc); } }
    __syncthreads();
    { const int mt = wid & 3, nh = wid >> 2, tok = 16 * mt + fr;
#pragma unroll
      for (int nbi = 0; nbi < 2; ++nbi) { const int nb = 2 * nh + nbi;
          f32x4 ga = (f32x4){0.f, 0.f, 0.f, 0.f}, gx = ga;
#pragma unroll
          for (int ks = 0; ks < 2; ++ks) {
              const bf16x8 xf = *(const LAS bf16x8*)(XCB + tok * 72 + 32 * ks + 8 * fq);
              const bf16x8 waf = *(const LAS bf16x8*)(WA + (16 * nb + fr) * 72 + 32 * ks + 8 * fq);
              const bf16x8 wxf = *(const LAS bf16x8*)(WX + (16 * nb + fr) * 72 + 32 * ks + 8 * fq);
              ga = __builtin_amdgcn_mfma_f32_16x16x32_bf16(waf, xf, ga, 0, 0, 0);
              gx = __builtin_amdgcn_mfma_f32_16x16x32_bf16(wxf, xf, gx, 0, 0, 0); }
#pragma unroll
          for (int r = 0; r < 4; ++r) { const int col = 16 * nb + 4 * fq + r, k = nbi * 4 + r;
              const float a_g = __builtin_amdgcn_rcpf(1.0f + __expf(-(ga[r] + hc.ba[k]))), x_g = __builtin_amdgcn_rcpf(1.0f + __expf(-(gx[r] + hc.bx[k])));
              const float la = a_g * hc.sp[k];
              const float a = __expf(la), x2 = 2.0f * la;
              const float ser = -x2 * (1.0f + x2 * (0.5f + x2 * (0.16666667f + x2 * (0.041666668f + x2 * (0.0083333338f + x2 * 0.0013888889f)))));
              const float om = x2 > -0.25f ? ser : 1.0f - a * a;
              AA[tok * 65 + col] = a; UU[tok * 65 + col] = __builtin_amdgcn_sqrtf(om) * x_g * XC[tok * 65 + col]; } } }
    __syncthreads();
}
__device__ __forceinline__ void mixer_lru_scan(const Params& p, LAS unsigned char* lds, const int tid, const int bid) {
    const int wid = __builtin_amdgcn_readfirstlane(tid >> 6), lane = tid & 63;
    LAS float* XIN = (LAS float*)(lds + L_XIN); LAS float* AA = (LAS float*)(lds + L_AA); LAS float* UU = (LAS float*)(lds + L_UU); LAS float* PART = (LAS float*)(lds + L_PART);
    float* RSA = (float*)(p.ws + WS_SUMA); float* RSH = (float*)(p.ws + WS_SUMH);
    const bf16_t* Z = (const bf16_t*)(p.ws + WS_Z); unsigned* HP = (unsigned*)(p.ws + WS_F);
    int hl = -1; HeadConst hc;
    for (int it = bid; it < NBATCH * 16 * NRUN; it += gridDim.x) {
        const int h = it & 15, b = it >> 8, run = ((it >> 4) + b) & 15, ch = 64 * h + lane;
        if (h != hl) { lru_load_head(p, lds, h, tid, hc); hl = h; }
        const int v0 = run == 0 ? -1 : 4 * run, v1 = 4 * run + 4;
        float cinH = 0.f, cinA = 1.f;
        XinRegs xr; xin_prefetch(Z, b, h, v0, tid, xr);
        for (int v = v0; v < v1; ++v) {
            const int ntok = v < 0 ? NMETA : 64;
            xin_store(XIN, tid, xr);
            __syncthreads();
            if (v + 1 < v1) xin_prefetch(Z, b, h, v + 1, tid, xr);
            lru_tile_math(lds, tid, hc);
            float a[8], u[8]; float A = 1.f, H = 0.f;
#pragma unroll
            for (int i = 0; i < 8; ++i) { const int t = 8 * wid + i; a[i] = AA[t * 65 + lane]; u[i] = UU[t * 65 + lane]; if (t < ntok) { H = a[i] * H + u[i]; A *= a[i]; } }
            PART[(wid * 2 + 0) * 64 + lane] = A; PART[(wid * 2 + 1) * 64 + lane] = H;
            __syncthreads();
            float hcur = cinH, pcur = cinA;
#pragma unroll
            for (int w = 0; w < 8; ++w) { const float pa = PART[(w * 2 + 0) * 64 + lane], ph = PART[(w * 2 + 1) * 64 + lane]; cinH = pa * cinH + ph; cinA *= pa; if (w < wid) { hcur = pa * hcur + ph; pcur *= pa; } }
            if (v >= 0) {
                unsigned* hp = HP + ((size_t)b * SEQ + 64 * v + 8 * wid) * DL + ch;
#pragma unroll
                for (int i = 0; i < 8; ++i) { hcur = a[i] * hcur + u[i]; pcur *= a[i]; hp[(size_t)i * DL] = cvt_pk_bf16(hcur, pcur); }
            }
        }
        if (wid == 0) { RSA[(size_t)(b * NRUN + run) * DL + ch] = cinA; RSH[(size_t)(b * NRUN + run) * DL + ch] = cinH; }
    }
}
__device__ __forceinline__ void mixer_lru_out(const Params& p, const int tid, const int bid) {
    const int wid = tid >> 6, lane = tid & 63;
    const float* RSA = (const float*)(p.ws + WS_SUMA); const float* RSH = (const float*)(p.ws + WS_SUMH);
    const bf16_t* Z = (const bf16_t*)(p.ws + WS_Z); const unsigned* HP = (const unsigned*)(p.ws + WS_F); bf16_t* MIX = (bf16_t*)p.out;
    for (int wi = bid * 8 + wid; wi < NBATCH * NRUN * 8 * 4; wi += gridDim.x * 8) {
        const int q = wi & 3, chunk = (wi >> 2) & 7, run = (wi >> 5) & 15, b = wi >> 9, col = 256 * q + 4 * lane;
        f32x4 cin = (f32x4){0.f, 0.f, 0.f, 0.f};
        { f32x4 sa[NRUN - 1], sh[NRUN - 1];
#pragma unroll
          for (int rr = 0; rr < NRUN - 1; ++rr) { const size_t o = (size_t)(b * NRUN + (rr < run ? rr : 0)) * DL + col; sa[rr] = *(const f32x4*)(RSA + o); sh[rr] = *(const f32x4*)(RSH + o); }
#pragma unroll
          for (int rr = 0; rr < NRUN - 1; ++rr) if (rr < run) cin = sa[rr] * cin + sh[rr]; }
        const f32x4 go = *(const f32x4*)(p.in[17] + col);
        const size_t row0 = (size_t)b * SEQ + 256 * run + 32 * chunk;
#pragma unroll 8
        for (int i = 0; i < 32; ++i) { const size_t row = row0 + i;
            const u32x4 hp = *(const u32x4*)(HP + row * DL + col);
            const u32x2 yw = *(const u32x2*)(Z + row * NINC + col);
            const f32x4 hh = (f32x4){bflo(hp.x) + bfhi(hp.x) * cin[0], bflo(hp.y) + bfhi(hp.y) * cin[1], bflo(hp.z) + bfhi(hp.z) * cin[2], bflo(hp.w) + bfhi(hp.w) * cin[3]};
            const f32x4 y = (f32x4){bflo(yw.x), bfhi(yw.x), bflo(yw.y), bfhi(yw.y)};
            f32x4 vv;
#pragma unroll
            for (int k = 0; k < 4; ++k) { const float z2 = y[k] * (1.5957691216057308f + 0.07135481627f * y[k] * y[k]);
                vv[k] = hh[k] * y[k] * __builtin_amdgcn_rcpf(1.0f + __expf(-z2)); }
            const float ss = row16_sum((vv[0] * vv[0] + vv[1] * vv[1]) + (vv[2] * vv[2] + vv[3] * vv[3]));
            const f32x4 r = vv * __builtin_amdgcn_rsqf(ss * (1.0f / 64.0f) + EPS) * go;
            u32x2 w; w.x = cvt_pk_bf16(r[0], r[1]); w.y = cvt_pk_bf16(r[2], r[3]);
            *(u32x2*)(MIX + row * D + col) = w; }
    }
}
__device__ __forceinline__ void mixer_sconv(const Params& p, const int tid, const int bid) {
    const int wid = tid >> 6, lane = tid & 63;
    const bf16_t* Z = (const bf16_t*)(p.ws + WS_Z); bf16_t* MIX = (bf16_t*)p.out;
    for (int wi = bid * 8 + wid; wi < NBATCH * 128 * 4; wi += gridDim.x * 8) {
        const int q = wi & 3, c32 = (wi >> 2) & 127, b = wi >> 9, col = 256 * q + 4 * lane;
        const f32x4 w0 = *(const f32x4*)(p.in[16] + col), w1 = *(const f32x4*)(p.in[16] + DL + col), w2 = *(const f32x4*)(p.in[16] + 2 * DL + col), gg = *(const f32x4*)(p.in[18] + col);
        const int t0 = 32 * c32, s = NMETA + t0;
        f32x4 cvm2, cvm1;
        { const size_t r2 = (size_t)zrow(b, s - 2) * NINC + col, r1 = (size_t)zrow(b, s - 1) * NINC + col;
          const u32x2 c2 = *(const u32x2*)(Z + r2 + 3 * DL), v2 = *(const u32x2*)(Z + r2 + 4 * DL), c1 = *(const u32x2*)(Z + r1 + 3 * DL), v1 = *(const u32x2*)(Z + r1 + 4 * DL);
          cvm2 = (f32x4){bflo(c2.x) * bflo(v2.x), bfhi(c2.x) * bfhi(v2.x), bflo(c2.y) * bflo(v2.y), bfhi(c2.y) * bfhi(v2.y)};
          cvm1 = (f32x4){bflo(c1.x) * bflo(v1.x), bfhi(c1.x) * bfhi(v1.x), bflo(c1.y) * bflo(v1.y), bfhi(c1.y) * bfhi(v1.y)}; }
#pragma unroll 8
        for (int i = 0; i < 32; ++i) { const size_t row = (size_t)b * SEQ + t0 + i; const size_t zr = row * NINC + col;
            const u32x2 cw = *(const u32x2*)(Z + zr + 3 * DL), vw = *(const u32x2*)(Z + zr + 4 * DL), bw = *(const u32x2*)(Z + zr + 2 * DL);
            const f32x4 cv0 = (f32x4){bflo(cw.x) * bflo(vw.x), bfhi(cw.x) * bfhi(vw.x), bflo(cw.y) * bflo(vw.y), bfhi(cw.y) * bfhi(vw.y)};
            const f32x4 bs = (f32x4){bflo(bw.x), bfhi(bw.x), bflo(bw.y), bfhi(bw.y)};
            const f32x4 o = bs * (w0 * cvm2 + w1 * cvm1 + w2 * cv0);
            const float ss = row16_sum((o[0] * o[0] + o[1] * o[1]) + (o[2] * o[2] + o[3] * o[3]));
            const f32x4 r = o * (rsqrtf(ss * (1.0f / 64.0f) + EPS)) * gg;
            u32x2 w; w.x = cvt_pk_bf16(r[0], r[1]); w.y = cvt_pk_bf16(r[2], r[3]);
            *(u32x2*)(MIX + row * D + DL + col) = w;
            cvm2 = cvm1; cvm1 = cv0; }
    }
}

#define XB_TMO      128
#define XB_XCNT(j)  (256  + 64 * (j))
#define XB_XSUB(j)  (1280 + 64 * (j))
#define XB_XGEN(j)  (2304 + 64 * (j))
#define XB_TOP      3328
#define XB_TOPGEN   3392
#define XCD_BAR_WORDS 3456
#define XB_SPIN_CAP (1u << 20)
__device__ __forceinline__ unsigned xb_ld(unsigned* p)              { return __hip_atomic_load(p, __ATOMIC_RELAXED, __HIP_MEMORY_SCOPE_AGENT); }
__device__ __forceinline__ unsigned xb_add(unsigned* p, unsigned v) { return __hip_atomic_fetch_add(p, v, __ATOMIC_RELAXED, __HIP_MEMORY_SCOPE_AGENT); }
__device__ __forceinline__ unsigned xb_xcc_id() { return (unsigned)__builtin_amdgcn_s_getreg((3 << 11) | 20) & 0xFu; }
#define XB_SPIN(cond, bar) do { unsigned _sp = 0; while (cond) { __builtin_amdgcn_s_sleep(1); \
    if ((++_sp & 255u) == 0u) { if (xb_ld(&(bar)[XB_TMO])) break; if (_sp > XB_SPIN_CAP) { atomicAdd(&(bar)[XB_TMO], 1u); break; } } } } while (0)
struct XcdBarrier { unsigned* bar; unsigned x; volatile LAS unsigned* st; };
__device__ __forceinline__ XcdBarrier xcd_barrier_post(unsigned* bar, volatile LAS unsigned* st) {
    XcdBarrier b; b.bar = bar; b.x = xb_xcc_id(); b.st = st;
    if (threadIdx.x == 0) (void)xb_add(&bar[XB_XCNT(b.x)], 1u);
    return b;
}
__device__ __forceinline__ void xcd_barrier_complete(unsigned* bar, unsigned x, unsigned& nloc, unsigned& nx) {
    const unsigned G = gridDim.x * gridDim.y * gridDim.z;
    unsigned sum, cnt, mine, sp = 0u;
    for (;;) {
        sum = 0u; cnt = 0u; mine = 0u;
#pragma unroll
        for (unsigned j = 0; j < 16; ++j) { const unsigned c = xb_ld(&bar[XB_XCNT(j)]); sum += c; cnt += (c > 0u) ? 1u : 0u; mine = (j == x) ? c : mine; }
        if (sum == G) break;
        __builtin_amdgcn_s_sleep(1);
        if ((++sp & 255u) == 0u) { if (xb_ld(&bar[XB_TMO])) break; if (sp > XB_SPIN_CAP) { atomicAdd(&bar[XB_TMO], 1u); break; } }
    }
    nloc = mine > 0u ? mine : 1u; nx = cnt > 0u ? cnt : 1u;
}
__device__ __forceinline__ void xcd_barrier(const XcdBarrier& b) {
    asm volatile("s_waitcnt vmcnt(0)" ::: "memory");
    __syncthreads();
    if (threadIdx.x == 0) {
        unsigned* bar = b.bar;
        __builtin_amdgcn_s_waitcnt(0);
        unsigned nloc = b.st[0], nx = b.st[1];
        if (nloc == 0u) { xcd_barrier_complete(bar, b.x, nloc, nx); b.st[0] = nloc; b.st[1] = nx; }
        const unsigned old = xb_add(&bar[XB_XSUB(b.x)], 1u);
        const unsigned gen = old / nloc;
        if (old + 1u == (gen + 1u) * nloc) {
            __builtin_amdgcn_fence(__ATOMIC_RELEASE, "agent");
            asm volatile("s_waitcnt vmcnt(0)" ::: "memory");
            const unsigned og = xb_add(&bar[XB_TOP], 1u);
            const unsigned tg = og / nx;
            if (og + 1u == (tg + 1u) * nx) xb_add(&bar[XB_TOPGEN], 1u);
            else XB_SPIN(xb_ld(&bar[XB_TOPGEN]) == tg, bar);
            __builtin_amdgcn_fence(__ATOMIC_ACQUIRE, "agent");
            xb_add(&bar[XB_XGEN(b.x)], 1u);
            asm volatile("s_waitcnt vmcnt(0)" ::: "memory");
        } else {
            XB_SPIN(xb_ld(&bar[XB_XGEN(b.x)]) == gen, bar);
            __builtin_amdgcn_fence(__ATOMIC_ACQUIRE, "agent");
            asm volatile("s_waitcnt vmcnt(0)" ::: "memory");
        }
    }
    __syncthreads();
}

__global__ void __launch_bounds__(512, 2) fwd_kernel(Params p) {
    extern __shared__ __attribute__((aligned(16))) unsigned char lds_raw[];
    LAS unsigned char* lds = (LAS unsigned char*)lds_raw;
    cg::grid_group grid = cg::this_grid();
    volatile LAS unsigned* xst = (volatile LAS unsigned*)(lds + LDS_MAIN);
    if (threadIdx.x == 0) { xst[0] = 0u; xst[1] = 0u; }
    __syncthreads();
    const XcdBarrier xbar = xcd_barrier_post((unsigned*)(p.ws + WS_BAR), xst);
    if (p.ph_hi > NPHASE + 100) grid.sync();
    bf16_t* W1A = (bf16_t*)(p.ws + WS_W1A); bf16_t* W1B = (bf16_t*)(p.ws + WS_W1B); bf16_t* WIN = (bf16_t*)(p.ws + WS_WIN); bf16_t* WOUT = (bf16_t*)(p.ws + WS_WOUT);
    bf16_t* W2A = (bf16_t*)(p.ws + WS_W2A); bf16_t* W2B = (bf16_t*)(p.ws + WS_W2B);
    bf16_t* HB = (bf16_t*)(p.ws + WS_ABUF); bf16_t* MIXB = (bf16_t*)p.out; float* RS = (float*)(p.ws + WS_RS); bf16_t* ACT = (bf16_t*)(p.ws + WS_ACT); bf16_t* FB = (bf16_t*)(p.ws + WS_F); bf16_t* ZB = (bf16_t*)(p.ws + WS_Z);
    for (int ph = p.ph_lo; ph < p.ph_hi; ++ph) {
      const int nrep = ((REPMASK >> ph) & 1) ? 2 : 1;
      for (int rep = 0; rep < nrep; ++rep) {
        int tid = threadIdx.x, bid = blockIdx.x;
        asm volatile("" : "+v"(tid), "+s"(bid));
        if (ph == 0 && (PHMASK & 1)) {
            prep_weights(p, lds, tid, bid);
            ew_phase<true>(nullptr, 0.f, nullptr, p.in[0], p.in[1], nullptr, nullptr, HB, RS, MROWS, tid, bid);
        } else if ((ph == 1 || ph == 9) && (PHMASK & 2)) {
            pg8::Gemm g{HB, ph == 1 ? W1A : W2A, MX, 2 * DFF, D}; pg8::StaticOrder S; S.init(MX, 2 * DFF, gridDim.x, bid);
            pg8::EpiSwiglu E{ACT, DFF, RS};
            pg8::gemm_phase<pg8::EpiSwiglu>(lds, g, S, E, tid);
            if (ph == 1) skinny16(lds, HB + (size_t)MX * D, D, W1A, DFF / 16, 1, ACT + (size_t)MX * DFF, DFF, RS + MX, tid, bid);
        } else if ((ph == 2 || ph == 4 || ph == 7 || ph == 10) && (PHMASK & 4)) {
            const bf16_t* A; const bf16_t* Bt; bf16_t* O; int N, K; const float* rs = nullptr;
            if (ph == 2)      { A = ACT;  Bt = W1B;  O = FB; N = D;    K = DFF; }
            else if (ph == 4) { A = HB;   Bt = WIN;  O = ZB; N = NINC; K = D; rs = RS; }
            else if (ph == 7) { A = MIXB; Bt = WOUT; O = FB; N = D;    K = D; }
            else              { A = ACT;  Bt = W2B;  O = FB; N = D;    K = DFF; }
            pg8::Gemm g{A, Bt, MX, N, K}; pg8::StaticOrder S; S.init(MX, N, gridDim.x, bid);
            pg8::EpiBf16 E{O, N, rs};
            pg8::gemm_phase<pg8::EpiBf16>(lds, g, S, E, tid);
            if (ph == 2 || ph == 4) skinny16(lds, A + (size_t)MX * K, K, Bt, N / 16, 0, O + (size_t)MX * N, N, rs ? rs + MX : nullptr, tid, bid);
        } else if ((ph == 3 || ph == 8 || ph == 11) && (PHMASK & 8)) {
            const float* gp = ph == 3 ? p.in[6] : (ph == 8 ? p.in[20] : p.in[25]);
            ew_phase<false>(FB, ph == 8 ? 1.0f : 0.5f, gp, nullptr, nullptr, HB, ph == 11 ? p.out : nullptr, ph == 11 ? nullptr : HB, RS, ph == 3 ? MROWS : MX, tid, bid);
        } else if (ph == 5 && (PHMASK & 16)) {
            mixer_lru_scan(p, lds, tid, bid); mixer_sconv(p, tid, bid);
        } else if (ph == 6 && (PHMASK & 32)) {
            mixer_lru_out(p, tid, bid);
        }
        if (ph + 1 < p.ph_hi || rep + 1 < nrep) xcd_barrier(xbar);
      }
    }
}

extern "C" void kernel_launch(void* const* d_in, const int* in_sizes, int n_in, void* d_out, int out_size, void* d_ws, size_t ws_size, hipStream_t stream) {
    static int grid = 0;
    if (grid == 0) {
        if (n_in != 26 || out_size != MX * D || ws_size < WS_END) { fprintf(stderr, "kernel_launch: unexpected shapes (n_in %d out %d ws %zu need %zu)\n", n_in, out_size, ws_size, (size_t)WS_END); grid = -1; return; }
        int dev = 0, cus = 0, per_cu = 0;
        hipGetDevice(&dev); hipDeviceGetAttribute(&cus, hipDeviceAttributeMultiprocessorCount, dev);
        if (hipFuncSetAttribute((const void*)fwd_kernel, hipFuncAttributeMaxDynamicSharedMemorySize, LDS_BYTES) != hipSuccess) { fprintf(stderr, "kernel_launch: hipFuncSetAttribute failed\n"); grid = -1; return; }
        if (hipOccupancyMaxActiveBlocksPerMultiprocessor(&per_cu, (const void*)fwd_kernel, 512, LDS_BYTES) != hipSuccess || per_cu < 1) { fprintf(stderr, "kernel_launch: occupancy query gave %d\n", per_cu); per_cu = 1; }
        (void)hipGetLastError();
        grid = cus * 1;
        fprintf(stderr, "kernel_launch: grid %d (cus %d, per_cu %d)\n", grid, cus, per_cu);
    }
    if (grid < 0) return;
    if (hipMemsetAsync((char*)d_ws + WS_BAR, 0, XCD_BAR_WORDS * 4, stream) != hipSuccess) { fprintf(stderr, "kernel_launch: memset of the barrier words failed\n"); return; }
    Params p{};
    for (int i = 0; i < 26; ++i) p.in[i] = (const float*)d_in[i];
    p.out = (float*)d_out; p.ws = (unsigned char*)d_ws;
#if ONE_LAUNCH
    p.ph_lo = 0; p.ph_hi = NPHASE;
    { void* args[] = {&p}; hipError_t e = hipLaunchCooperativeKernel((const void*)fwd_kernel, dim3(grid), dim3(512), args, LDS_BYTES, stream);
      if (e != hipSuccess) fprintf(stderr, "cooperative launch failed: %s\n", hipGetErrorString(e)); }
#else
    for (int ph = 0; ph < NPHASE; ++ph) {
        p.ph_lo = ph; p.ph_hi = ph + 1;
        void* args[] = {&p}; hipError_t e = hipLaunchCooperativeKernel((const void*)fwd_kernel, dim3(grid), dim3(512), args, LDS_BYTES, stream);
        if (e != hipSuccess) { fprintf(stderr, "cooperative launch %d failed: %s\n", ph, hipGetErrorString(e)); break; }
    }
#endif
}
```

```cpp
#include <hip/hip_runtime.h>
#include <hip/hip_cooperative_groups.h>
#include <cstdio>
namespace cg = cooperative_groups;

#ifndef PHMASK
#define PHMASK 0xFFF
#endif
#ifndef REPMASK
#define REPMASK 0
#endif
#ifndef ONE_LAUNCH
#define ONE_LAUNCH 1
#endif

#define LAS __attribute__((address_space(3)))
typedef unsigned short bf16_t;
typedef short bf16x8 __attribute__((ext_vector_type(8)));
typedef float f32x4 __attribute__((ext_vector_type(4)));
typedef unsigned u32x4 __attribute__((ext_vector_type(4)));
typedef unsigned u32x2 __attribute__((ext_vector_type(2)));

constexpr int D = 2048, DFF = 5504, DL = 1024, NINC = 5120, SEQ = 4096, NBATCH = 4, NMETA = 16;
constexpr int MX = NBATCH * SEQ;
constexpr int MROWS = MX + NMETA;
constexpr int NTILE = 65;
constexpr float EPS = 1e-6f;
constexpr int NPHASE = 12;
constexpr int LDS_MAIN = 131072, LDS_RS_OFF = LDS_MAIN + 64, LDS_RS_UNITS = 24, LDS_BYTES = LDS_RS_OFF + LDS_RS_UNITS * 1024;

constexpr size_t SZ_WA = (size_t)2 * DFF * D * 2, SZ_WB = (size_t)D * DFF * 2, SZ_WIN = (size_t)NINC * D * 2, SZ_WOUT = (size_t)D * D * 2;
constexpr size_t WS_W1A = 0, WS_W1B = WS_W1A + SZ_WA, WS_WIN = WS_W1B + SZ_WB, WS_WOUT = WS_WIN + SZ_WIN, WS_W2A = WS_WOUT + SZ_WOUT, WS_W2B = WS_W2A + SZ_WA;
constexpr size_t WS_ABUF = WS_W2B + SZ_WB;
constexpr size_t WS_ACT = WS_ABUF + (size_t)MROWS * D * 2;
constexpr size_t WS_F = WS_ACT + (size_t)MROWS * DFF * 2;
constexpr size_t WS_Z = WS_ACT;
constexpr size_t WS_SUMA = WS_F + (size_t)MROWS * D * 2;
constexpr size_t WS_SUMH = WS_SUMA + (size_t)NBATCH * NTILE * DL * 4;
constexpr size_t WS_BAR = WS_SUMH + (size_t)NBATCH * NTILE * DL * 4;
constexpr size_t WS_RS = WS_BAR + 16384;
constexpr size_t WS_END = WS_RS + 65792;
static_assert((size_t)MROWS * NINC * 2 <= (size_t)MROWS * DFF * 2 + (size_t)MROWS * D * 2, "Z must fit in ACT+F");

struct Params { const float* in[26]; float* out; unsigned char* ws; int ph_lo, ph_hi; };

__device__ __forceinline__ unsigned cvt_pk_bf16(float lo, float hi) { unsigned r; asm volatile("v_cvt_pk_bf16_f32 %0, %1, %2" : "=v"(r) : "v"(lo), "v"(hi)); return r; }
__device__ __forceinline__ bf16_t f2bf(float x) { return (bf16_t)(cvt_pk_bf16(x, 0.f) & 0xffffu); }
__device__ __forceinline__ float bf2f(bf16_t h) { return __uint_as_float(((unsigned)h) << 16); }
__device__ __forceinline__ float bflo(unsigned w) { return __uint_as_float(w << 16); }
__device__ __forceinline__ float bfhi(unsigned w) { return __uint_as_float(w & 0xffff0000u); }
__device__ __forceinline__ float wave_sum(float v) {
#pragma unroll
    for (int o = 32; o >= 1; o >>= 1) v += __shfl_xor(v, o);
    return v;
}
template <int CTRL> __device__ __forceinline__ float dpp_f(float v) { return __builtin_bit_cast(float, __builtin_amdgcn_update_dpp(0, __builtin_bit_cast(int, v), CTRL, 0xf, 0xf, true)); }
__device__ __forceinline__ float row16_sum(float v) {
    v += dpp_f<0xB1>(v); v += dpp_f<0x4E>(v); v += dpp_f<0x141>(v); v += dpp_f<0x140>(v); return v;
}
__device__ __forceinline__ float wave64_sum(float v) {
    const float r = row16_sum(v); const int ri = __builtin_bit_cast(int, r);
    return __builtin_bit_cast(float, __builtin_amdgcn_readlane(ri, 0)) + __builtin_bit_cast(float, __builtin_amdgcn_readlane(ri, 16)) + __builtin_bit_cast(float, __builtin_amdgcn_readlane(ri, 32)) + __builtin_bit_cast(float, __builtin_amdgcn_readlane(ri, 48));
}
__device__ __forceinline__ float silu_f(float g) { return g * __builtin_amdgcn_rcpf(1.0f + __expf(-g)); }
__device__ __forceinline__ float sigmoid_f(float g) { return 1.0f / (1.0f + __expf(-g)); }
__device__ __forceinline__ float gelu_tanh_f(float y) { const float t = tanhf(0.7978845608028654f * (y + 0.044715f * y * y * y)); return 0.5f * y * (1.0f + t); }
__device__ __forceinline__ int zrow(int b, int s) { return s < NMETA ? MX + s : b * SEQ + (s - NMETA); }

namespace pg8 {
constexpr int BM = 256, BK = 64, HALF = 128, HTB = HALF * BK * 2, STAGE_BYTES = 8 * HTB, NXCD = 8;
__device__ __forceinline__ int lds_byte(int r, int c) { const int st = (r >> 4) * 2 + (c >> 5), rr = r & 15, cc = c & 31, ob = rr * 64 + cc * 2; return st * 1024 + (ob ^ (((ob >> 9) & 1) << 5)); }
__device__ __forceinline__ void stage_rc(int b, int& R, int& C) { const int st = b / 1024, sb = b % 1024, swz = sb ^ (((sb >> 9) & 1) << 5); R = (st >> 1) * 16 + swz / 64; C = (st & 1) * 32 + (swz % 64) / 2; }
__device__ __forceinline__ int perm32(int rho) { const int n = rho >> 4, i = rho & 15; return 8 * (i >> 2) + 4 * n + (i & 3); }
struct Unit { int pm, pn; };
struct Gemm { const bf16_t* A; const bf16_t* Bt; int M, N, K; };
struct StaticOrder {
    int nM, nN, nwg, G, c, WGM;
    __device__ void init(int M, int N, int G_, int c_) { nM = M / BM; nN = N / BM; nwg = nM * nN; G = G_; c = c_; WGM = nN == 8 ? 4 : 8; }
    __device__ bool next(int i, Unit& u) const {
        const long L = (long)i * G + c; if (L >= nwg) return false;
        int wgid = (int)L; { const int q = nwg / NXCD, r = nwg % NXCD, xcd = wgid % NXCD, off = wgid / NXCD; wgid = (xcd < r ? xcd * (q + 1) : r * (q + 1) + (xcd - r) * q) + off; }
        const int nig = WGM * nN, gid = wgid / nig, fm = gid * WGM, gsz = (nM - fm) < WGM ? (nM - fm) : WGM;
        u.pm = fm + ((wgid % nig) % gsz); u.pn = (wgid % nig) / gsz; return true;
    }
};
struct EpiBf16 {
    static constexpr bool PERM = true;
    bf16_t* O; int ldc; const float* rs;
    __device__ __forceinline__ void operator()(const f32x4 (&acc)[2][2][4][2], const Unit& u, int wr, int wc, int fr, int fq, const LAS float* rsl) const {
        const int row0 = u.pm * BM + wr * 64 + fr, col0 = u.pn * BM + wc * 32 + 8 * fq;
#pragma unroll
        for (int ai = 0; ai < 2; ++ai)
#pragma unroll
            for (int m = 0; m < 4; ++m) { bf16_t* rowp = O + (size_t)(row0 + ai * HALF + m * 16) * ldc + col0; const float sc = rs ? rsl[wr * 64 + fr + ai * HALF + m * 16] : 1.0f;
#pragma unroll
                for (int bj = 0; bj < 2; ++bj) { const f32x4 v0 = acc[ai][bj][m][0] * sc, v1 = acc[ai][bj][m][1] * sc;
                    u32x4 w; w.x = cvt_pk_bf16(v0[0], v0[1]); w.y = cvt_pk_bf16(v0[2], v0[3]); w.z = cvt_pk_bf16(v1[0], v1[1]); w.w = cvt_pk_bf16(v1[2], v1[3]);
                    *(u32x4*)(rowp + bj * HALF) = w; } }
    }
};
struct EpiSwiglu {
    static constexpr bool PERM = true;
    bf16_t* O; int ldc; const float* rs;
    __device__ __forceinline__ void operator()(const f32x4 (&acc)[2][2][4][2], const Unit& u, int wr, int wc, int fr, int fq, const LAS float* rsl) const {
        const int row0 = u.pm * BM + wr * 64 + fr, col0 = u.pn * HALF + wc * 32 + 8 * fq;
#pragma unroll
        for (int ai = 0; ai < 2; ++ai)
#pragma unroll
            for (int m = 0; m < 4; ++m) { bf16_t* rowp = O + (size_t)(row0 + ai * HALF + m * 16) * ldc + col0;
                const float sc = rsl[wr * 64 + fr + ai * HALF + m * 16], k1 = -1.4426950408889634f * sc, sc2 = sc * sc;
                const f32x4 g0 = acc[ai][0][m][0], g1 = acc[ai][0][m][1], u0 = acc[ai][1][m][0], u1 = acc[ai][1][m][1];
                float v[8];
                typedef float f32x2 __attribute__((ext_vector_type(2)));
#pragma unroll
                for (int hq = 0; hq < 4; ++hq) { const f32x4 gq = hq < 2 ? g0 : g1, uq = hq < 2 ? u0 : u1; const int o = (hq & 1) * 2;
                    const f32x2 g2 = (f32x2){gq[o], gq[o + 1]}, u2 = (f32x2){uq[o], uq[o + 1]};
                    f32x2 e = g2 * k1; e.x = __builtin_amdgcn_exp2f(e.x); e.y = __builtin_amdgcn_exp2f(e.y);
                    const f32x2 d = e + 1.0f; f32x2 r; r.x = __builtin_amdgcn_rcpf(d.x); r.y = __builtin_amdgcn_rcpf(d.y);
                    const f32x2 ov = (g2 * u2) * (r * sc2);
                    v[(hq >> 1) * 4 + o] = ov.x; v[(hq >> 1) * 4 + o + 1] = ov.y; }
                u32x4 w; w.x = cvt_pk_bf16(v[0], v[1]); w.y = cvt_pk_bf16(v[2], v[3]); w.z = cvt_pk_bf16(v[4], v[5]); w.w = cvt_pk_bf16(v[6], v[7]);
                *(u32x4*)rowp = w; }
    }
};

template <class Epi>
__device__ __forceinline__ void gemm_phase(LAS unsigned char* lds, const Gemm g, const StaticOrder& S, const Epi& E, const int tid) {
    const int wid = __builtin_amdgcn_readfirstlane(tid >> 6), lane = tid & 63, wr = wid >> 2, wc = wid & 3, fr = lane & 15, fq = lane >> 4;
    const int K = g.K, nt = K / BK;
    unsigned voffA[2], voffB[2];
#pragma unroll
    for (int i = 0; i < 2; ++i) { int R, C; stage_rc(tid * 16 + i * 8192, R, C); const int Rb = Epi::PERM ? ((R & ~31) + perm32(R & 31)) : R;
        voffA[i] = (unsigned)(R * K + C) * 2u; voffB[i] = (unsigned)(Rb * K + C) * 2u; }
    const size_t kstep = (size_t)(BK * 2);
    const size_t hstep = (size_t)HALF * K * 2;
    const size_t tstep = 2 * hstep;
    const unsigned ldsw = (unsigned)wid * 1024u;
    const int aoff = lds_byte(wr * 64 + fr, fq * 8), boff = lds_byte(wc * 32 + fr, fq * 8);
#define PG8_SA(b, h) (((b) * 2 + (h)) * HTB)
#define PG8_SB(b, h) ((4 + (b) * 2 + (h)) * HTB)
#define PG8_STAGE(bufoff, gbase, voff) do { _Pragma("unroll") for (int _i = 0; _i < 2; ++_i) \
        __builtin_amdgcn_global_load_lds((const unsigned*)((const char*)(gbase) + (voff)[_i]), (LAS unsigned*)(lds + (bufoff) + ldsw + _i * 8192), 16, 0, 0); } while (0)
#define PG8_LDA(dst, b, h) do { _Pragma("unroll") for (int m = 0; m < 4; ++m) _Pragma("unroll") for (int k = 0; k < 2; ++k) dst[m][k] = *(const LAS bf16x8*)(lds + PG8_SA(b, h) + aoff + m * 2048 + k * 1024); } while (0)
#define PG8_LDB(dst, b, h) do { _Pragma("unroll") for (int n = 0; n < 2; ++n) _Pragma("unroll") for (int k = 0; k < 2; ++k) dst[n][k] = *(const LAS bf16x8*)(lds + PG8_SB(b, h) + boff + n * 2048 + k * 1024); } while (0)
#define PG8_MMA(ai, bj, At, Bt) do { __builtin_amdgcn_s_setprio(1); _Pragma("unroll") for (int m = 0; m < 4; ++m) _Pragma("unroll") for (int n = 0; n < 2; ++n) _Pragma("unroll") for (int k = 0; k < 2; ++k) \
        acc[ai][bj][m][n] = __builtin_amdgcn_mfma_f32_16x16x32_bf16(Bt[n][k], At[m][k], acc[ai][bj][m][n], 0, 0, 0); __builtin_amdgcn_s_setprio(0); } while (0)
#define PG8_WAIT_V(n) asm volatile("s_waitcnt vmcnt(" #n ")" ::: "memory")
#define PG8_WAIT_L(n) asm volatile("s_waitcnt lgkmcnt(" #n ")" ::: "memory")
#define PG8_BAR __builtin_amdgcn_s_barrier()
#define PG8_SCHED __builtin_amdgcn_sched_barrier(0)
    Unit cur, nxt; int ui = 0;
    LAS float* rsl = (LAS float*)(lds + LDS_RS_OFF);
    if (E.rs) { Unit uu; for (int i = 0; i < LDS_RS_UNITS && S.next(i, uu); ++i) if (tid < 256) rsl[i * 256 + tid] = E.rs[uu.pm * BM + tid]; }
    __syncthreads();
    if (!S.next(0, cur)) return;
    f32x4 acc[2][2][4][2];
#pragma unroll
    for (int a = 0; a < 2; ++a)
#pragma unroll
        for (int b = 0; b < 2; ++b)
#pragma unroll
            for (int m = 0; m < 4; ++m)
#pragma unroll
                for (int n = 0; n < 2; ++n) acc[a][b][m][n] = (f32x4){0.f, 0.f, 0.f, 0.f};
    bf16x8 At[4][2], B0[2][2], B1[2][2];
    const char* cA = (const char*)g.A + (size_t)cur.pm * tstep; const char* cB = (const char*)g.Bt + (size_t)cur.pn * tstep;
    PG8_STAGE(PG8_SB(0, 0), cB, voffB); PG8_STAGE(PG8_SA(0, 0), cA, voffA); PG8_STAGE(PG8_SB(0, 1), cB + hstep, voffB); PG8_STAGE(PG8_SA(0, 1), cA + hstep, voffA);
    if (wr == 1) PG8_BAR;
    PG8_WAIT_V(4); PG8_BAR;
    PG8_STAGE(PG8_SB(1, 0), cB + kstep, voffB); PG8_STAGE(PG8_SA(1, 0), cA + kstep, voffA); PG8_STAGE(PG8_SB(1, 1), cB + hstep + kstep, voffB);
    PG8_WAIT_V(6); PG8_BAR;
    for (;;) {
        const bool has_next = S.next(ui + 1, nxt);
        const char* nA = has_next ? (const char*)g.A + (size_t)nxt.pm * tstep : cA; const char* nB = has_next ? (const char*)g.Bt + (size_t)nxt.pn * tstep : cB;
        for (int t = 0; t < nt; t += 2) {
            const bool last = (t == nt - 2);
            const char* a1 = cA + (size_t)(t + 1) * kstep;
            const char* a2 = last ? nA : cA + (size_t)(t + 2) * kstep; const char* b2 = last ? nB : cB + (size_t)(t + 2) * kstep;
            const char* a3 = a2 + kstep; const char* b3 = b2 + kstep;
            PG8_LDB(B0, 0, 0); PG8_SCHED; PG8_LDA(At, 0, 0); PG8_STAGE(PG8_SA(1, 1), a1 + hstep, voffA);
            PG8_WAIT_L(8); PG8_BAR; PG8_WAIT_L(0); PG8_MMA(0, 0, At, B0); PG8_BAR; PG8_SCHED;
            PG8_LDB(B1, 0, 1); PG8_STAGE(PG8_SB(0, 0), b2, voffB);
            PG8_BAR; PG8_WAIT_L(0); PG8_MMA(0, 1, At, B1); PG8_BAR;
            PG8_LDA(At, 0, 1); PG8_STAGE(PG8_SA(0, 0), a2, voffA);
            PG8_BAR; PG8_WAIT_L(0); PG8_MMA(1, 0, At, B0); PG8_BAR; PG8_SCHED;
            PG8_STAGE(PG8_SB(0, 1), b2 + hstep, voffB);
            PG8_WAIT_V(6); PG8_BAR; PG8_MMA(1, 1, At, B1); PG8_BAR;
            PG8_LDB(B0, 1, 0); PG8_SCHED; PG8_LDA(At, 1, 0); PG8_STAGE(PG8_SA(0, 1), a2 + hstep, voffA);
            PG8_WAIT_L(8); PG8_BAR; PG8_WAIT_L(0); PG8_MMA(0, 0, At, B0); PG8_BAR; PG8_SCHED;
            PG8_LDB(B1, 1, 1); PG8_STAGE(PG8_SB(1, 0), b3, voffB);
            PG8_BAR; PG8_WAIT_L(0); PG8_MMA(0, 1, At, B1); PG8_BAR;
            PG8_LDA(At, 1, 1); PG8_STAGE(PG8_SA(1, 0), a3, voffA);
            PG8_BAR; PG8_WAIT_L(0); PG8_MMA(1, 0, At, B0); PG8_BAR; PG8_SCHED;
            PG8_STAGE(PG8_SB(1, 1), b3 + hstep, voffB);
            PG8_WAIT_V(6); PG8_BAR; PG8_MMA(1, 1, At, B1); PG8_BAR;
        }
        E(acc, cur, wr, wc, fr, fq, rsl + ui * 256);
        if (!has_next) break;
#pragma unroll
        for (int a = 0; a < 2; ++a)
#pragma unroll
            for (int b = 0; b < 2; ++b)
#pragma unroll
                for (int m = 0; m < 4; ++m)
#pragma unroll
                    for (int n = 0; n < 2; ++n) acc[a][b][m][n] = (f32x4){0.f, 0.f, 0.f, 0.f};
        cur = nxt; cA = nA; cB = nB; ++ui;
    }
    PG8_WAIT_V(0);
    if (wr == 0) PG8_BAR;
    PG8_BAR;
#undef PG8_SA
#undef PG8_SB
#undef PG8_STAGE
#undef PG8_LDA
#undef PG8_LDB
#undef PG8_MMA
#undef PG8_WAIT_V
#undef PG8_WAIT_L
#undef PG8_BAR
#undef PG8_SCHED
}
}

__device__ __forceinline__ void skinny16(LAS unsigned char* lds, const bf16_t* A, int K, const bf16_t* Bt, int ntiles, int mode, bf16_t* O, int ldo, const float* rs, const int tid, const int bid) {
    const int wid = __builtin_amdgcn_readfirstlane(tid >> 6), lane = tid & 63, fr = lane & 15, fq = lane >> 4;
    LAS f32x4* RED = (LAS f32x4*)lds;
    const int nsteps = K / 32;
    for (int tile = (int)gridDim.x - 1 - bid; tile < ntiles; tile += gridDim.x) {
        const int c0 = 16 * tile, rb0 = mode ? ((c0 >> 7) * 256 + (c0 & 127)) : c0;
        f32x4 acc0 = (f32x4){0.f, 0.f, 0.f, 0.f}, acc1 = (f32x4){0.f, 0.f, 0.f, 0.f};
        const bf16_t* ap = A + (size_t)fr * K + fq * 8;
        const bf16_t* bp0 = Bt + (size_t)(rb0 + fr) * K + fq * 8;
        const bf16_t* bp1 = bp0 + (size_t)128 * K;
        for (int s = wid; s < nsteps; s += 32) {
            bf16x8 a[4], b0[4], b1[4];
#pragma unroll
            for (int j = 0; j < 4; ++j) { const int sj = s + 8 * j, sc = sj < nsteps ? sj : s;
                a[j] = *(const bf16x8*)(ap + sc * 32); b0[j] = *(const bf16x8*)(bp0 + sc * 32); if (mode) b1[j] = *(const bf16x8*)(bp1 + sc * 32); }
#pragma unroll
            for (int j = 0; j < 4; ++j) if (s + 8 * j < nsteps) {
                acc0 = __builtin_amdgcn_mfma_f32_16x16x32_bf16(b0[j], a[j], acc0, 0, 0, 0);
                if (mode) acc1 = __builtin_amdgcn_mfma_f32_16x16x32_bf16(b1[j], a[j], acc1, 0, 0, 0); }
        }
        RED[(wid * 2 + 0) * 64 + lane] = acc0; RED[(wid * 2 + 1) * 64 + lane] = acc1;
        __syncthreads();
        if (wid == 0) {
            f32x4 s0 = (f32x4){0.f, 0.f, 0.f, 0.f}, s1 = s0;
#pragma unroll
            for (int w = 0; w < 8; ++w) { s0 += RED[(w * 2 + 0) * 64 + lane]; s1 += RED[(w * 2 + 1) * 64 + lane]; }
            if (rs) { const float sc = rs[fr]; s0 *= sc; s1 *= sc; }
            if (mode) {
#pragma unroll
                for (int j = 0; j < 4; ++j) s0[j] = silu_f(s0[j]) * s1[j];
            }
            u32x2 w; w.x = cvt_pk_bf16(s0[0], s0[1]); w.y = cvt_pk_bf16(s0[2], s0[3]);
            *(u32x2*)(O + (size_t)fr * ldo + c0 + 4 * fq) = w;
        }
        __syncthreads();
    }
}

struct TileDesc { const float* src; bf16_t* dst; const float* g; int N, K; };
__device__ __forceinline__ TileDesc decode_tile(const Params& p, int g) {
    const float* W; bf16_t* out; const float* gn = nullptr; int K, N, mode, loc;
    if (g < 688)       { W = p.in[3];  out = (bf16_t*)(p.ws + WS_W1A); K = D;   N = DFF;  mode = 1; loc = g; gn = p.in[2]; }
    else if (g < 1376) { W = p.in[4];  out = (bf16_t*)(p.ws + WS_W1A); K = D;   N = DFF;  mode = 2; loc = g - 688; gn = p.in[2]; }
    else if (g < 2064) { W = p.in[5];  out = (bf16_t*)(p.ws + WS_W1B); K = DFF; N = D;    mode = 0; loc = g - 1376; }
    else if (g < 2704) { W = p.in[8];  out = (bf16_t*)(p.ws + WS_WIN); K = D;   N = NINC; mode = 0; loc = g - 2064; gn = p.in[7]; }
    else if (g < 2960) { W = p.in[19]; out = (bf16_t*)(p.ws + WS_WOUT); K = D;  N = D;    mode = 0; loc = g - 2704; }
    else if (g < 3648) { W = p.in[22]; out = (bf16_t*)(p.ws + WS_W2A); K = D;   N = DFF;  mode = 1; loc = g - 2960; gn = p.in[21]; }
    else if (g < 4336) { W = p.in[23]; out = (bf16_t*)(p.ws + WS_W2A); K = D;   N = DFF;  mode = 2; loc = g - 3648; gn = p.in[21]; }
    else               { W = p.in[24]; out = (bf16_t*)(p.ws + WS_W2B); K = DFF; N = D;    mode = 0; loc = g - 4336; }
    const int nNt = N / 128, kt = loc / nNt, ntl = loc % nNt;
    const int rowbase = mode == 0 ? ntl * 128 : ntl * 256 + (mode == 2 ? 128 : 0);
    TileDesc t; t.src = W + (size_t)(kt * 128) * N + ntl * 128; t.dst = out + (size_t)rowbase * K + kt * 128; t.g = gn ? gn + kt * 128 : nullptr; t.N = N; t.K = K; return t;
}
constexpr int PREP_TILES = 5024;
__device__ __forceinline__ void prep_weights(const Params& p, LAS unsigned char* lds, const int tid, const int bid) {
    LAS float* T = (LAS float*)lds;
    const int r = tid >> 5, c4 = tid & 31;
    int g = bid;
    if (g >= PREP_TILES) return;
    TileDesc td = decode_tile(p, g);
    f32x4 v[8];
#pragma unroll
    for (int i = 0; i < 8; ++i) v[i] = *(const f32x4*)(td.src + (size_t)(r + 16 * i) * td.N + 4 * c4);
    for (;;) {
#pragma unroll
        for (int i = 0; i < 8; ++i) { const int k = r + 16 * i; *(LAS f32x4*)(T + k * 132 + 4 * (c4 ^ ((k >> 3) & 7))) = v[i]; }
        __syncthreads();
        const int gn = g + gridDim.x; const bool has_next = gn < PREP_TILES;
        TileDesc tn = td;
        if (has_next) { tn = decode_tile(p, gn);
#pragma unroll
            for (int i = 0; i < 8; ++i) v[i] = *(const f32x4*)(tn.src + (size_t)(r + 16 * i) * tn.N + 4 * c4); }
#pragma unroll
        for (int p2 = 0; p2 < 4; ++p2) { const int cch = tid & 15, nn = (tid >> 4) + 32 * p2, k8 = 8 * cch, ncol = nn ^ (4 * (cch & 7)); float x[8];
#pragma unroll
            for (int i = 0; i < 8; ++i) x[i] = T[(k8 + i) * 132 + ncol];
            if (td.g) { const f32x4 g0 = *(const f32x4*)(td.g + k8), g1 = *(const f32x4*)(td.g + k8 + 4);
                x[0] *= g0[0]; x[1] *= g0[1]; x[2] *= g0[2]; x[3] *= g0[3]; x[4] *= g1[0]; x[5] *= g1[1]; x[6] *= g1[2]; x[7] *= g1[3]; }
            u32x4 w; w.x = cvt_pk_bf16(x[0], x[1]); w.y = cvt_pk_bf16(x[2], x[3]); w.z = cvt_pk_bf16(x[4], x[5]); w.w = cvt_pk_bf16(x[6], x[7]);
            *(u32x4*)(td.dst + (size_t)nn * td.K + k8) = w; }
        __syncthreads();
        if (!has_next) break;
        g = gn; td = tn;
    }
}

template <bool HX> struct EwRows { f32x4 hf[HX ? 2 : 1][HX ? 8 : 1]; u32x2 hw[HX ? 1 : 2][HX ? 1 : 8]; u32x2 fw[HX ? 1 : 2][HX ? 1 : 8]; int rr[2]; };
template <bool HX> __device__ __forceinline__ void ew_load(EwRows<HX>& R, int r0, int nw, int nrows, const bf16_t* F, const float* hx, const float* meta, const bf16_t* hb, int lane) {
    R.rr[0] = r0; R.rr[1] = (r0 + nw < nrows) ? r0 + nw : r0;
#pragma unroll
    for (int q = 0; q < 2; ++q) { const int r = R.rr[q];
        if constexpr (HX) { const float* hp = r < MX ? hx + (size_t)r * D : meta + (size_t)(r - MX) * D;
#pragma unroll
            for (int i = 0; i < 8; ++i) R.hf[q][i] = *(const f32x4*)(hp + i * 256 + lane * 4); }
        else {
#pragma unroll
            for (int i = 0; i < 8; ++i) R.hw[q][i] = *(const u32x2*)(hb + (size_t)r * D + i * 256 + lane * 4);
#pragma unroll
            for (int i = 0; i < 8; ++i) R.fw[q][i] = *(const u32x2*)(F + (size_t)r * D + i * 256 + lane * 4); } }
}
template <bool HX> __device__ __forceinline__ void ew_phase(const bf16_t* F, float coef, const float* gpost, const float* hx, const float* meta, const bf16_t* hb, float* out32, bf16_t* hbo, float* rso, int nrows, const int tid, const int bid) {
    const int lane = tid & 63, gw = bid * 8 + (tid >> 6), nw = gridDim.x * 8;
    if (gw >= nrows) return;
    EwRows<HX> R; ew_load<HX>(R, gw, nw, nrows, F, hx, meta, hb, lane);
    for (int r0 = gw; r0 < nrows; r0 += 2 * nw) {
        EwRows<HX> Nx; const bool has_next = r0 + 2 * nw < nrows;
        if (has_next) ew_load<HX>(Nx, r0 + 2 * nw, nw, nrows, F, hx, meta, hb, lane);
#pragma unroll
        for (int q = 0; q < 2; ++q) { const int r = R.rr[q];
            f32x4 h[8];
#pragma unroll
            for (int i = 0; i < 8; ++i) { if constexpr (HX) h[i] = R.hf[q][i]; else { const u32x2 w = R.hw[q][i]; h[i] = (f32x4){bflo(w.x), bfhi(w.x), bflo(w.y), bfhi(w.y)}; } }
            if constexpr (!HX) {
                f32x4 f[8]; float ss = 0.f;
#pragma unroll
                for (int i = 0; i < 8; ++i) { const u32x2 w = R.fw[q][i]; f[i] = (f32x4){bflo(w.x), bfhi(w.x), bflo(w.y), bfhi(w.y)}; ss += (f[i][0] * f[i][0] + f[i][1] * f[i][1]) + (f[i][2] * f[i][2] + f[i][3] * f[i][3]); }
                ss = wave64_sum(ss);
                const float rs = coef * rsqrtf(ss * (1.0f / D) + EPS);
#pragma unroll
                for (int i = 0; i < 8; ++i) { const f32x4 g = *(const f32x4*)(gpost + i * 256 + lane * 4); h[i] += f[i] * rs * g; }
            }
            if (out32 && r < MX) {
#pragma unroll
                for (int i = 0; i < 8; ++i) *(f32x4*)(out32 + (size_t)r * D + i * 256 + lane * 4) = h[i];
            }
            if (hbo) {
                float ss = 0.f;
#pragma unroll
                for (int i = 0; i < 8; ++i) ss += (h[i][0] * h[i][0] + h[i][1] * h[i][1]) + (h[i][2] * h[i][2] + h[i][3] * h[i][3]);
                ss = wave64_sum(ss);
                if (lane == 0) rso[r] = rsqrtf(ss * (1.0f / D) + EPS);
#pragma unroll
                for (int i = 0; i < 8; ++i) { u32x2 w; w.x = cvt_pk_bf16(h[i][0], h[i][1]); w.y = cvt_pk_bf16(h[i][2], h[i][3]);
                    *(u32x2*)(hbo + (size_t)r * D + i * 256 + lane * 4) = w; }
            }
        }
        if (has_next) R = Nx;
    }
}

constexpr int L_XIN = 0, L_XC = 17152, L_AA = L_XC + 16640, L_UU = L_AA + 16640, L_XCB = L_UU + 16640, L_WA = L_XCB + 9216, L_WX = L_WA + 9216, L_PART = L_WX + 9216, L_END = L_PART + 4096;
static_assert(L_END <= LDS_MAIN, "mixer LDS");
constexpr int NRUN = 16;
struct HeadConst { float cw0, cw1, cw2, cw3, cb, go; float sp[8], ba[8], bx[8]; };
__device__ __forceinline__ void lru_load_head(const Params& p, LAS unsigned char* lds, int h, const int tid, HeadConst& hc) {
    LAS bf16_t* WA = (LAS bf16_t*)(lds + L_WA); LAS bf16_t* WX = (LAS bf16_t*)(lds + L_WX);
    const float* wa = p.in[11] + (size_t)h * 4096; const float* wx = p.in[13] + (size_t)h * 4096;
    for (int e = tid; e < 4096; e += 512) { const int i = e >> 6, j = e & 63; WA[j * 72 + i] = f2bf(wa[e]); WX[j * 72 + i] = f2bf(wx[e]); }
    const int lane = tid & 63, wid = tid >> 6, fq = lane >> 4, nh = wid >> 2, ch = 64 * h + lane;
    hc.cw0 = p.in[9][ch]; hc.cw1 = p.in[9][DL + ch]; hc.cw2 = p.in[9][2 * DL + ch]; hc.cw3 = p.in[9][3 * DL + ch]; hc.cb = p.in[10][ch]; hc.go = p.in[17][ch];
#pragma unroll
    for (int k = 0; k < 8; ++k) { const int c2 = 64 * h + 16 * (2 * nh + (k >> 2)) + 4 * fq + (k & 3);
        hc.sp[k] = -8.0f * log1pf(__expf(-p.in[15][c2])); hc.ba[k] = p.in[12][c2]; hc.bx[k] = p.in[14][c2]; }
}
struct XinRegs { u32x4 a, b; };
__device__ __forceinline__ void xin_prefetch(const bf16_t* Z, int b, int h, int v, const int tid, XinRegs& x) {
    const int s0 = v < 0 ? 0 : NMETA + 64 * v, ntok = v < 0 ? NMETA : 64;
    x.a = (u32x4){0u, 0u, 0u, 0u}; x.b = x.a;
    { const int row = tid >> 3, seg = tid & 7, s = s0 - 3 + row; if (s >= 0 && row < ntok + 3) x.a = *(const u32x4*)(Z + (size_t)zrow(b, s) * NINC + DL + 64 * h + 8 * seg); }
    if (tid < 24) { const int e = 512 + tid, row = e >> 3, seg = e & 7, s = s0 - 3 + row; if (s >= 0 && row < ntok + 3) x.b = *(const u32x4*)(Z + (size_t)zrow(b, s) * NINC + DL + 64 * h + 8 * seg); }
}
__device__ __forceinline__ void xin_store(LAS float* XIN, const int tid, const XinRegs& x) {
    { LAS float* d = XIN + tid * 8; *(LAS f32x4*)d = (f32x4){bflo(x.a.x), bfhi(x.a.x), bflo(x.a.y), bfhi(x.a.y)}; *(LAS f32x4*)(d + 4) = (f32x4){bflo(x.a.z), bfhi(x.a.z), bflo(x.a.w), bfhi(x.a.w)}; }
    if (tid < 24) { LAS float* d = XIN + (512 + tid) * 8; *(LAS f32x4*)d = (f32x4){bflo(x.b.x), bfhi(x.b.x), bflo(x.b.y), bfhi(x.b.y)}; *(LAS f32x4*)(d + 4) = (f32x4){bflo(x.b.z), bfhi(x.b.z), bflo(x.b.w), bfhi(x.b.w)}; }
}
__device__ __forceinline__ void lru_tile_math(LAS unsigned char* lds, const int tid, const HeadConst& hc) {
    const int wid = __builtin_amdgcn_readfirstlane(tid >> 6), lane = tid & 63, fr = lane & 15, fq = lane >> 4;
    LAS float* XIN = (LAS float*)(lds + L_XIN); LAS float* XC = (LAS float*)(lds + L_XC); LAS float* AA = (LAS float*)(lds + L_AA); LAS float* UU = (LAS float*)(lds + L_UU);
    LAS bf16_t* XCB = (LAS bf16_t*)(lds + L_XCB); LAS bf16_t* WA = (LAS bf16_t*)(lds + L_WA); LAS bf16_t* WX = (LAS bf16_t*)(lds + L_WX);
    { const int c = lane;
#pragma unroll
      for (int q = 0; q < 8; ++q) { const int t = wid + 8 * q;
          const float xc = hc.cb + hc.cw0 * XIN[t * 64 + c] + hc.cw1 * XIN[(t + 1) * 64 + c] + hc.cw2 * XIN[(t + 2) * 64 + c] + hc.cw3 * XIN[(t + 3) * 64 + c];
          XC[t * 65 + c] = xc; XCB[t * 72 + c] = f2bf(xc); } }
    __syncthreads();
    { const int mt = wid & 3, nh = wid >> 2, tok = 16 * mt + fr;
#pragma unroll
      for (int nbi = 0; nbi < 2; ++nbi) { const int nb = 2 * nh + nbi;
          f32x4 ga = (f32x4){0.f, 0.f, 0.f, 0.f}, gx = ga;
#pragma unroll
          for (int ks = 0; ks < 2; ++ks) {
              const bf16x8 xf = *(const LAS bf16x8*)(XCB + tok * 72 + 32 * ks + 8 * fq);
              const bf16x8 waf = *(const LAS bf16x8*)(WA + (16 * nb + fr) * 72 + 32 * ks + 8 * fq);
              const bf16x8 wxf = *(const LAS bf16x8*)(WX + (16 * nb + fr) * 72 + 32 * ks + 8 * fq);
              ga = __builtin_amdgcn_mfma_f32_16x16x32_bf16(waf, xf, ga, 0, 0, 0);
              gx = __builtin_amdgcn_mfma_f32_16x16x32_bf16(wxf, xf, gx, 0, 0, 0); }
#pragma unroll
          for (int r = 0; r < 4; ++r) { const int col = 16 * nb + 4 * fq + r, k = nbi * 4 + r;
              const float a_g = __builtin_amdgcn_rcpf(1.0f + __expf(-(ga[r] + hc.ba[k]))), x_g = __builtin_amdgcn_rcpf(1.0f + __expf(-(gx[r] + hc.bx[k])));
              const float la = a_g * hc.sp[k];
              const float a = __expf(la), x2 = 2.0f * la;
              const float ser = -x2 * (1.0f + x2 * (0.5f + x2 * (0.16666667f + x2 * (0.041666668f + x2 * (0.0083333338f + x2 * 0.0013888889f)))));
              const float om = x2 > -0.25f ? ser : 1.0f - a * a;
              AA[tok * 65 + col] = a; UU[tok * 65 + col] = __builtin_amdgcn_sqrtf(om) * x_g * XC[tok * 65 + col]; } } }
    __syncthreads();
}
__device__ __forceinline__ void mixer_lru_scan(const Params& p, LAS unsigned char* lds, const int tid, const int bid) {
    const int wid = __builtin_amdgcn_readfirstlane(tid >> 6), lane = tid & 63;
    LAS float* XIN = (LAS float*)(lds + L_XIN); LAS float* AA = (LAS float*)(lds + L_AA); LAS float* UU = (LAS float*)(lds + L_UU); LAS float* PART = (LAS float*)(lds + L_PART);
    float* RSA = (float*)(p.ws + WS_SUMA); float* RSH = (float*)(p.ws + WS_SUMH);
    const bf16_t* Z = (const bf16_t*)(p.ws + WS_Z); unsigned* HP = (unsigned*)(p.ws + WS_F);
    int hl = -1; HeadConst hc;
    for (int it = bid; it < NBATCH * 16 * NRUN; it += gridDim.x) {
        const int h = it & 15, b = it >> 8, run = ((it >> 4) + b) & 15, ch = 64 * h + lane;
        if (h != hl) { lru_load_head(p, lds, h, tid, hc); hl = h; }
        const int v0 = run == 0 ? -1 : 4 * run, v1 = 4 * run + 4;
        float cinH = 0.f, cinA = 1.f;
        XinRegs xr; xin_prefetch(Z, b, h, v0, tid, xr);
        for (int v = v0; v < v1; ++v) {
            const int ntok = v < 0 ? NMETA : 64;
            xin_store(XIN, tid, xr);
            __syncthreads();
            if (v + 1 < v1) xin_prefetch(Z, b, h, v + 1, tid, xr);
            lru_tile_math(lds, tid, hc);
            float a[8], u[8]; float A = 1.f, H = 0.f;
#pragma unroll
            for (int i = 0; i < 8; ++i) { const int t = 8 * wid + i; a[i] = AA[t * 65 + lane]; u[i] = UU[t * 65 + lane]; if (t < ntok) { H = a[i] * H + u[i]; A *= a[i]; } }
            PART[(wid * 2 + 0) * 64 + lane] = A; PART[(wid * 2 + 1) * 64 + lane] = H;
            __syncthreads();
            float hcur = cinH, pcur = cinA;
#pragma unroll
            for (int w = 0; w < 8; ++w) { const float pa = PART[(w * 2 + 0) * 64 + lane], ph = PART[(w * 2 + 1) * 64 + lane]; cinH = pa * cinH + ph; cinA *= pa; if (w < wid) { hcur = pa * hcur + ph; pcur *= pa; } }
            if (v >= 0) {
                unsigned* hp = HP + ((size_t)b * SEQ + 64 * v + 8 * wid) * DL + ch;
#pragma unroll
                for (int i = 0; i < 8; ++i) { hcur = a[i] * hcur + u[i]; pcur *= a[i]; hp[(size_t)i * DL] = cvt_pk_bf16(hcur, pcur); }
            }
        }
        if (wid == 0) { RSA[(size_t)(b * NRUN + run) * DL + ch] = cinA; RSH[(size_t)(b * NRUN + run) * DL + ch] = cinH; }
    }
}
__device__ __forceinline__ void mixer_lru_out(const Params& p, const int tid, const int bid) {
    const int wid = tid >> 6, lane = tid & 63;
    const float* RSA = (const float*)(p.ws + WS_SUMA); const float* RSH = (const float*)(p.ws + WS_SUMH);
    const bf16_t* Z = (const bf16_t*)(p.ws + WS_Z); const unsigned* HP = (const unsigned*)(p.ws + WS_F); bf16_t* MIX = (bf16_t*)p.out;
    for (int wi = bid * 8 + wid; wi < NBATCH * NRUN * 8 * 4; wi += gridDim.x * 8) {
        const int q = wi & 3, chunk = (wi >> 2) & 7, run = (wi >> 5) & 15, b = wi >> 9, col = 256 * q + 4 * lane;
        f32x4 cin = (f32x4){0.f, 0.f, 0.f, 0.f};
        { f32x4 sa[NRUN - 1], sh[NRUN - 1];
#pragma unroll
          for (int rr = 0; rr < NRUN - 1; ++rr) { const size_t o = (size_t)(b * NRUN + (rr < run ? rr : 0)) * DL + col; sa[rr] = *(const f32x4*)(RSA + o); sh[rr] = *(const f32x4*)(RSH + o); }
#pragma unroll
          for (int rr = 0; rr < NRUN - 1; ++rr) if (rr < run) cin = sa[rr] * cin + sh[rr]; }
        const f32x4 go = *(const f32x4*)(p.in[17] + col);
        const size_t row0 = (size_t)b * SEQ + 256 * run + 32 * chunk;
#pragma unroll 8
        for (int i = 0; i < 32; ++i) { const size_t row = row0 + i;
            const u32x4 hp = *(const u32x4*)(HP + row * DL + col);
            const u32x2 yw = *(const u32x2*)(Z + row * NINC + col);
            const f32x4 hh = (f32x4){bflo(hp.x) + bfhi(hp.x) * cin[0], bflo(hp.y) + bfhi(hp.y) * cin[1], bflo(hp.z) + bfhi(hp.z) * cin[2], bflo(hp.w) + bfhi(hp.w) * cin[3]};
            const f32x4 y = (f32x4){bflo(yw.x), bfhi(yw.x), bflo(yw.y), bfhi(yw.y)};
            f32x4 vv;
#pragma unroll
            for (int k = 0; k < 4; ++k) { const float z2 = y[k] * (1.5957691216057308f + 0.07135481627f * y[k] * y[k]);
                vv[k] = hh[k] * y[k] * __builtin_amdgcn_rcpf(1.0f + __expf(-z2)); }
            const float ss = row16_sum((vv[0] * vv[0] + vv[1] * vv[1]) + (vv[2] * vv[2] + vv[3] * vv[3]));
            const f32x4 r = vv * __builtin_amdgcn_rsqf(ss * (1.0f / 64.0f) + EPS) * go;
            u32x2 w; w.x = cvt_pk_bf16(r[0], r[1]); w.y = cvt_pk_bf16(r[2], r[3]);
            *(u32x2*)(MIX + row * D + col) = w; }
    }
}
__device__ __forceinline__ void mixer_sconv(const Params& p, const int tid, const int bid) {
    const int wid = tid >> 6, lane = tid & 63;
    const bf16_t* Z = (const bf16_t*)(p.ws + WS_Z); bf16_t* MIX = (bf16_t*)p.out;
    for (int wi = bid * 8 + wid; wi < NBATCH * 128 * 4; wi += gridDim.x * 8) {
        const int q = wi & 3, c32 = (wi >> 2) & 127, b = wi >> 9, col = 256 * q + 4 * lane;
        const f32x4 w0 = *(const f32x4*)(p.in[16] + col), w1 = *(const f32x4*)(p.in[16] + DL + col), w2 = *(const f32x4*)(p.in[16] + 2 * DL + col), gg = *(const f32x4*)(p.in[18] + col);
        const int t0 = 32 * c32, s = NMETA + t0;
        f32x4 cvm2, cvm1;
        { const size_t r2 = (size_t)zrow(b, s - 2) * NINC + col, r1 = (size_t)zrow(b, s - 1) * NINC + col;
          const u32x2 c2 = *(const u32x2*)(Z + r2 + 3 * DL), v2 = *(const u32x2*)(Z + r2 + 4 * DL), c1 = *(const u32x2*)(Z + r1 + 3 * DL), v1 = *(const u32x2*)(Z + r1 + 4 * DL);
          cvm2 = (f32x4){bflo(c2.x) * bflo(v2.x), bfhi(c2.x) * bfhi(v2.x), bflo(c2.y) * bflo(v2.y), bfhi(c2.y) * bfhi(v2.y)};
          cvm1 = (f32x4){bflo(c1.x) * bflo(v1.x), bfhi(c1.x) * bfhi(v1.x), bflo(c1.y) * bflo(v1.y), bfhi(c1.y) * bfhi(v1.y)}; }
#pragma unroll 8
        for (int i = 0; i < 32; ++i) { const size_t row = (size_t)b * SEQ + t0 + i; const size_t zr = row * NINC + col;
            const u32x2 cw = *(const u32x2*)(Z + zr + 3 * DL), vw = *(const u32x2*)(Z + zr + 4 * DL), bw = *(const u32x2*)(Z + zr + 2 * DL);
            const f32x4 cv0 = (f32x4){bflo(cw.x) * bflo(vw.x), bfhi(cw.x) * bfhi(vw.x), bflo(cw.y) * bflo(vw.y), bfhi(cw.y) * bfhi(vw.y)};
            const f32x4 bs = (f32x4){bflo(bw.x), bfhi(bw.x), bflo(bw.y), bfhi(bw.y)};
            const f32x4 o = bs * (w0 * cvm2 + w1 * cvm1 + w2 * cv0);
            const float ss = row16_sum((o[0] * o[0] + o[1] * o[1]) + (o[2] * o[2] + o[3] * o[3]));
            const f32x4 r = o * (rsqrtf(ss * (1.0f / 64.0f) + EPS)) * gg;
            u32x2 w; w.x = cvt_pk_bf16(r[0], r[1]); w.y = cvt_pk_bf16(r[2], r[3]);
            *(u32x2*)(MIX + row * D + DL + col) = w;
            cvm2 = cvm1; cvm1 = cv0; }
    }
}

#define XB_TMO      128
#define XB_XCNT(j)  (256  + 64 * (j))
#define XB_XSUB(j)  (1280 + 64 * (j))
#define XB_XGEN(j)  (2304 + 64 * (j))
#define XB_TOP      3328
#define XB_TOPGEN   3392
#define XCD_BAR_WORDS 3456
#define XB_SPIN_CAP (1u << 20)
__device__ __forceinline__ unsigned xb_ld(unsigned* p)              { return __hip_atomic_load(p, __ATOMIC_RELAXED, __HIP_MEMORY_SCOPE_AGENT); }
__device__ __forceinline__ unsigned xb_add(unsigned* p, unsigned v) { return __hip_atomic_fetch_add(p, v, __ATOMIC_RELAXED, __HIP_MEMORY_SCOPE_AGENT); }
__device__ __forceinline__ unsigned xb_xcc_id() { return (unsigned)__builtin_amdgcn_s_getreg((3 << 11) | 20) & 0xFu; }
#define XB_SPIN(cond, bar) do { unsigned _sp = 0; while (cond) { __builtin_amdgcn_s_sleep(1); \
    if ((++_sp & 255u) == 0u) { if (xb_ld(&(bar)[XB_TMO])) break; if (_sp > XB_SPIN_CAP) { atomicAdd(&(bar)[XB_TMO], 1u); break; } } } } while (0)
struct XcdBarrier { unsigned* bar; unsigned x; volatile LAS unsigned* st; };
__device__ __forceinline__ XcdBarrier xcd_barrier_post(unsigned* bar, volatile LAS unsigned* st) {
    XcdBarrier b; b.bar = bar; b.x = xb_xcc_id(); b.st = st;
    if (threadIdx.x == 0) (void)xb_add(&bar[XB_XCNT(b.x)], 1u);
    return b;
}
__device__ __forceinline__ void xcd_barrier_complete(unsigned* bar, unsigned x, unsigned& nloc, unsigned& nx) {
    const unsigned G = gridDim.x * gridDim.y * gridDim.z;
    unsigned sum, cnt, mine, sp = 0u;
    for (;;) {
        sum = 0u; cnt = 0u; mine = 0u;
#pragma unroll
        for (unsigned j = 0; j < 16; ++j) { const unsigned c = xb_ld(&bar[XB_XCNT(j)]); sum += c; cnt += (c > 0u) ? 1u : 0u; mine = (j == x) ? c : mine; }
        if (sum == G) break;
        __builtin_amdgcn_s_sleep(1);
        if ((++sp & 255u) == 0u) { if (xb_ld(&bar[XB_TMO])) break; if (sp > XB_SPIN_CAP) { atomicAdd(&bar[XB_TMO], 1u); break; } }
    }
    nloc = mine > 0u ? mine : 1u; nx = cnt > 0u ? cnt : 1u;
}
__device__ __forceinline__ void xcd_barrier(const XcdBarrier& b) {
    asm volatile("s_waitcnt vmcnt(0)" ::: "memory");
    __syncthreads();
    if (threadIdx.x == 0) {
        unsigned* bar = b.bar;
        __builtin_amdgcn_s_waitcnt(0);
        unsigned nloc = b.st[0], nx = b.st[1];
        if (nloc == 0u) { xcd_barrier_complete(bar, b.x, nloc, nx); b.st[0] = nloc; b.st[1] = nx; }
        const unsigned old = xb_add(&bar[XB_XSUB(b.x)], 1u);
        const unsigned gen = old / nloc;
        if (old + 1u == (gen + 1u) * nloc) {
            __builtin_amdgcn_fence(__ATOMIC_RELEASE, "agent");
            asm volatile("s_waitcnt vmcnt(0)" ::: "memory");
            const unsigned og = xb_add(&bar[XB_TOP], 1u);
            const unsigned tg = og / nx;
            if (og + 1u == (tg + 1u) * nx) xb_add(&bar[XB_TOPGEN], 1u);
            else XB_SPIN(xb_ld(&bar[XB_TOPGEN]) == tg, bar);
            __builtin_amdgcn_fence(__ATOMIC_ACQUIRE, "agent");
            xb_add(&bar[XB_XGEN(b.x)], 1u);
            asm volatile("s_waitcnt vmcnt(0)" ::: "memory");
        } else {
            XB_SPIN(xb_ld(&bar[XB_XGEN(b.x)]) == gen, bar);
            __builtin_amdgcn_fence(__ATOMIC_ACQUIRE, "agent");
            asm volatile("s_waitcnt vmcnt(0)" ::: "memory");
        }
    }
    __syncthreads();
}

__global__ void __launch_bounds__(512, 2) fwd_kernel(Params p) {
    extern __shared__ __attribute__((aligned(16))) unsigned char lds_raw[];
    LAS unsigned char* lds = (LAS unsigned char*)lds_raw;
    cg::grid_group grid = cg::this_grid();
    volatile LAS unsigned* xst = (volatile LAS unsigned*)(lds + LDS_MAIN);
    if (threadIdx.x == 0) { xst[0] = 0u; xst[1] = 0u; }
    __syncthreads();
    const XcdBarrier xbar = xcd_barrier_post((unsigned*)(p.ws + WS_BAR), xst);
    if (p.ph_hi > NPHASE + 100) grid.sync();
    bf16_t* W1A = (bf16_t*)(p.ws + WS_W1A); bf16_t* W1B = (bf16_t*)(p.ws + WS_W1B); bf16_t* WIN = (bf16_t*)(p.ws + WS_WIN); bf16_t* WOUT = (bf16_t*)(p.ws + WS_WOUT);
    bf16_t* W2A = (bf16_t*)(p.ws + WS_W2A); bf16_t* W2B = (bf16_t*)(p.ws + WS_W2B);
    bf16_t* HB = (bf16_t*)(p.ws + WS_ABUF); bf16_t* MIXB = (bf16_t*)p.out; float* RS = (float*)(p.ws + WS_RS); bf16_t* ACT = (bf16_t*)(p.ws + WS_ACT); bf16_t* FB = (bf16_t*)(p.ws + WS_F); bf16_t* ZB = (bf16_t*)(p.ws + WS_Z);
    for (int ph = p.ph_lo; ph < p.ph_hi; ++ph) {
      const int nrep = ((REPMASK >> ph) & 1) ? 2 : 1;
      for (int rep = 0; rep < nrep; ++rep) {
        int tid = threadIdx.x, bid = blockIdx.x;
        asm volatile("" : "+v"(tid), "+s"(bid));
        if (ph == 0 && (PHMASK & 1)) {
            prep_weights(p, lds, tid, bid);
            ew_phase<true>(nullptr, 0.f, nullptr, p.in[0], p.in[1], nullptr, nullptr, HB, RS, MROWS, tid, bid);
        } else if ((ph == 1 || ph == 9) && (PHMASK & 2)) {
            pg8::Gemm g{HB, ph == 1 ? W1A : W2A, MX, 2 * DFF, D}; pg8::StaticOrder S; S.init(MX, 2 * DFF, gridDim.x, bid);
            pg8::EpiSwiglu E{ACT, DFF, RS};
            pg8::gemm_phase<pg8::EpiSwiglu>(lds, g, S, E, tid);
            if (ph == 1) skinny16(lds, HB + (size_t)MX * D, D, W1A, DFF / 16, 1, ACT + (size_t)MX * DFF, DFF, RS + MX, tid, bid);
        } else if ((ph == 2 || ph == 4 || ph == 7 || ph == 10) && (PHMASK & 4)) {
            const bf16_t* A; const bf16_t* Bt; bf16_t* O; int N, K; const float* rs = nullptr;
            if (ph == 2)      { A = ACT;  Bt = W1B;  O = FB; N = D;    K = DFF; }
            else if (ph == 4) { A = HB;   Bt = WIN;  O = ZB; N = NINC; K = D; rs = RS; }
            else if (ph == 7) { A = MIXB; Bt = WOUT; O = FB; N = D;    K = D; }
            else              { A = ACT;  Bt = W2B;  O = FB; N = D;    K = DFF; }
            pg8::Gemm g{A, Bt, MX, N, K}; pg8::StaticOrder S; S.init(MX, N, gridDim.x, bid);
            pg8::EpiBf16 E{O, N, rs};
            pg8::gemm_phase<pg8::EpiBf16>(lds, g, S, E, tid);
            if (ph == 2 || ph == 4) skinny16(lds, A + (size_t)MX * K, K, Bt, N / 16, 0, O + (size_t)MX * N, N, rs ? rs + MX : nullptr, tid, bid);
        } else if ((ph == 3 || ph == 8 || ph == 11) && (PHMASK & 8)) {
            const float* gp = ph == 3 ? p.in[6] : (ph == 8 ? p.in[20] : p.in[25]);
            ew_phase<false>(FB, ph == 8 ? 1.0f : 0.5f, gp, nullptr, nullptr, HB, ph == 11 ? p.out : nullptr, ph == 11 ? nullptr : HB, RS, ph == 3 ? MROWS : MX, tid, bid);
        } else if (ph == 5 && (PHMASK & 16)) {
            mixer_lru_scan(p, lds, tid, bid); mixer_sconv(p, tid, bid);
        } else if (ph == 6 && (PHMASK & 32)) {
            mixer_lru_out(p, tid, bid);
        }
        if (ph + 1 < p.ph_hi || rep + 1 < nrep) xcd_barrier(xbar);
      }
    }
}

extern "C" void kernel_launch(void* const* d_in, const int* in_sizes, int n_in, void* d_out, int out_size, void* d_ws, size_t ws_size, hipStream_t stream) {
    static int grid = 0;
    if (grid == 0) {
        if (n_in != 26 || out_size != MX * D || ws_size < WS_END) { fprintf(stderr, "kernel_launch: unexpected shapes (n_in %d out %d ws %zu need %zu)\n", n_in, out_size, ws_size, (size_t)WS_END); grid = -1; return; }
        int dev = 0, cus = 0, per_cu = 0;
        hipGetDevice(&dev); hipDeviceGetAttribute(&cus, hipDeviceAttributeMultiprocessorCount, dev);
        if (hipFuncSetAttribute((const void*)fwd_kernel, hipFuncAttributeMaxDynamicSharedMemorySize, LDS_BYTES) != hipSuccess) { fprintf(stderr, "kernel_launch: hipFuncSetAttribute failed\n"); grid = -1; return; }
        if (hipOccupancyMaxActiveBlocksPerMultiprocessor(&per_cu, (const void*)fwd_kernel, 512, LDS_BYTES) != hipSuccess || per_cu < 1) { fprintf(stderr, "kernel_launch: occupancy query gave %d\n", per_cu); per_cu = 1; }
        (void)hipGetLastError();
        grid = cus * 1;
        fprintf(stderr, "kernel_launch: grid %d (cus %d, per_cu %d)\n", grid, cus, per_cu);
    }
    if (grid < 0) return;
    if (hipMemsetAsync((char*)d_ws + WS_BAR, 0, XCD_BAR_WORDS * 4, stream) != hipSuccess) { fprintf(stderr, "kernel_launch: memset of the barrier words failed\n"); return; }
    Params p{};
    for (int i = 0; i < 26; ++i) p.in[i] = (const float*)d_in[i];
    p.out = (float*)d_out; p.ws = (unsigned char*)d_ws;
#if ONE_LAUNCH
    p.ph_lo = 0; p.ph_hi = NPHASE;
    { void* args[] = {&p}; hipError_t e = hipLaunchCooperativeKernel((const void*)fwd_kernel, dim3(grid), dim3(512), args, LDS_BYTES, stream);
      if (e != hipSuccess) fprintf(stderr, "cooperative launch failed: %s\n", hipGetErrorString(e)); }
#else
    for (int ph = 0; ph < NPHASE; ++ph) {
        p.ph_lo = ph; p.ph_hi = ph + 1;
        void* args[] = {&p}; hipError_t e = hipLaunchCooperativeKernel((const void*)fwd_kernel, dim3(grid), dim3(512), args, LDS_BYTES, stream);
        if (e != hipSuccess) { fprintf(stderr, "cooperative launch %d failed: %s\n", ph, hipGetErrorString(e)); break; }
    }
#endif
}
```
